# Optimizing an MI355X kernel written in HIP

```python
import math
import jax, jax.numpy as jnp
from jax import lax
import numpy as np

D_MODEL = 1024
BATCH = 2
SEQ = 8192
DEPTH = 2
DEC_BATCH = 16
DEC_SEQ = 64
PAST_LEN = 2048

CHUNK = 64
N_A = DEPTH // 2
N_B = DEPTH - N_A
D_FF = 2816
RWKV_HEAD = 64
RWKV_HEADS = D_MODEL // RWKV_HEAD
DECAY_LORA = 64
A_LORA = 64
GATE_LORA = 128
GN_EPS = 64e-5
N_HEADS_B = 8
HEAD_QK = D_MODEL // N_HEADS_B // 2
HEAD_V = 2 * HEAD_QK
QK_W = N_HEADS_B * 2 * HEAD_QK
V_W = N_HEADS_B * HEAD_V
ROT_DIM = HEAD_QK // 4
ROPE_THETA = 500000.0
ATTN_SCALE = HEAD_QK ** -0.5
Q_BLOCK = 128
NORM_EPS = 1e-6
NEG_INF = -1e30

kernel_name = "streaming_rwkv7_diffattn_yoco"

F32 = jnp.float32


def _rms(x, g):
    x32 = x.astype(F32)
    y = x32 * lax.rsqrt(jnp.mean(x32 * x32, axis=-1, keepdims=True) + NORM_EPS) * g.astype(F32)
    return y.astype(x.dtype)


def _modulate(h, shift, scale):
    return h * (1.0 + scale) + shift


def _swiglu(h, w_in, w_out):
    gu = h @ w_in
    gate, up = jnp.split(gu, 2, axis=-1)
    return (jax.nn.silu(gate) * up) @ w_out


def _rope(x, pos):
    half = ROT_DIM // 2
    inv = ROPE_THETA ** (-jnp.arange(half, dtype=F32) * 2.0 / ROT_DIM)
    ang = pos.astype(F32)[:, None] * inv[None, :]
    cos = jnp.cos(ang)[None, :, None, None, :]
    sin = jnp.sin(ang)[None, :, None, None, :]
    xf = x.astype(F32)
    x1 = xf[..., :half]
    x2 = xf[..., half:ROT_DIM]
    out = jnp.concatenate([x1 * cos - x2 * sin, x2 * cos + x1 * sin, xf[..., ROT_DIM:]], axis=-1)
    return out.astype(x.dtype)


def _rwkv_step(S, inp):
    r_t, w_t, k_t, v_t, kk_t, b_t = inp
    sa = jnp.einsum('bhvk,bhk->bhv', S, -kk_t)
    S = S * w_t[:, :, None, :] + sa[..., None] * b_t[:, :, None, :] + v_t[..., None] * k_t[:, :, None, :]
    y = jnp.einsum('bhvk,bhk->bhv', S, r_t)
    return S, y


def _rwkv7_time_mix(h, shift_row, S0, i, P):
    B, T, D = h.shape
    dt = h.dtype
    mu = P['rwkv_mu'][i]
    xprev = jnp.concatenate([shift_row.astype(dt), h[:, :-1]], axis=1)
    dx = xprev - h
    xr, xw, xk, xv, xa, xg = [h + dx * mu[j] for j in range(6)]
    W = P['rwkv_w_rkv'][i]
    r = xr @ W[0]
    k = xk @ W[1]
    v = xv @ W[2]
    z = (P['rwkv_w0'][i] + jnp.tanh(xw @ P['rwkv_w1'][i]) @ P['rwkv_w2'][i]).astype(F32)
    w_log = -jax.nn.softplus(-z) - 0.5
    decay = jnp.exp(-jnp.exp(w_log))
    a = jax.nn.sigmoid((P['rwkv_a0'][i] + (xa @ P['rwkv_a1'][i]) @ P['rwkv_a2'][i]).astype(F32))
    g = jax.nn.sigmoid(xg @ P['rwkv_g1'][i]) @ P['rwkv_g2'][i]

    def heads(t):
        return t.astype(F32).reshape(B, T, RWKV_HEADS, RWKV_HEAD)

    kk = heads(k * P['rwkv_k_k'][i])
    kk = kk / jnp.maximum(jnp.linalg.norm(kk, axis=-1, keepdims=True), 1e-12)
    k = k.astype(F32) * (1.0 + (a - 1.0) * P['rwkv_k_a'][i].astype(F32))
    r_h, k_h, v_h, w_h, a_h = heads(r), heads(k), heads(v), heads(decay), heads(a)

    def tm(t):
        return jnp.moveaxis(t, 1, 0)

    S_T, y = lax.scan(_rwkv_step, S0.astype(F32),
                      (tm(r_h), tm(w_h), tm(k_h), tm(v_h), tm(kk), tm(kk * a_h)))
    y = jnp.moveaxis(y, 0, 1)
    mean = jnp.mean(y, axis=-1, keepdims=True)
    var = jnp.mean(jnp.square(y - mean), axis=-1, keepdims=True)
    y = ((y - mean) * lax.rsqrt(var + GN_EPS)).reshape(B, T, D)
    y = y * P['rwkv_ln_w'][i].astype(F32) + P['rwkv_ln_b'][i].astype(F32)
    bonus = (jnp.sum(r_h * k_h * P['rwkv_r_k'][i].astype(F32), axis=-1, keepdims=True) * v_h).reshape(B, T, D)
    out = ((y + bonus) * g.astype(F32)).astype(dt) @ P['rwkv_w_o'][i]
    return out, S_T, h[:, -1:]


def _diff_attend(q, qpos, k, v, kpos, lam):
    s = jnp.einsum('bqhcd,bkhcd->bhcqk', q.astype(F32), k) * ATTN_SCALE
    visible = (kpos // CHUNK)[None, :] <= (qpos // CHUNK)[:, None]
    s = jnp.where(visible, s, NEG_INF)
    p = jax.nn.softmax(s, axis=-1)
    a = p[:, :, 0] - lam * p[:, :, 1]
    return jnp.einsum('bhqk,bkhd->bqhd', a, v)


def _attend(q, qpos, k, v, kpos, lam):
    B, T = q.shape[0], q.shape[1]
    if T <= Q_BLOCK:
        return _diff_attend(q, qpos, k, v, kpos, lam)
    nb = T // Q_BLOCK
    qb = jnp.moveaxis(q.reshape(B, nb, Q_BLOCK, N_HEADS_B, 2, HEAD_QK), 1, 0)
    pb = qpos.reshape(nb, Q_BLOCK)
    ob = lax.map(lambda args: _diff_attend(args[0], args[1], k, v, kpos, lam), (qb, pb))
    return jnp.moveaxis(ob, 0, 1).reshape(B, T, N_HEADS_B, HEAD_V)


def _diff_attn_layer(h, qpos, k_all, v_all, kpos, j, layer_idx, P):
    B, T, _ = h.shape
    lam_init = 0.8 - 0.6 * math.exp(-0.3 * layer_idx)
    lp = P['diff_lambda'][j].astype(F32)
    lam = jnp.exp(jnp.sum(lp[0] * lp[1])) - jnp.exp(jnp.sum(lp[2] * lp[3])) + lam_init
    q = _rope((h @ P['diff_w_q'][j]).reshape(B, T, N_HEADS_B, 2, HEAD_QK), qpos)
    o = _attend(q, qpos, k_all, v_all, kpos, lam)
    o = o * lax.rsqrt(jnp.mean(o * o, axis=-1, keepdims=True) + NORM_EPS)
    o = o * P['diff_subln_g'][j].astype(F32) * (1.0 - lam_init)
    return o.reshape(B, T, V_W).astype(h.dtype) @ P['diff_w_o'][j]


def _trunk(x, c, past_len, wkv_init, shift_init, k_past, v_past, P):
    B, T, _ = x.shape
    dt = x.dtype
    pos = past_len + jnp.arange(T)
    sc = jax.nn.silu(c)
    new_wkv, new_shift = [], []
    k_new = v_new = k_all = v_all = kpos = None
    for l in range(DEPTH):
        if l == N_A:
            kv_mod = (sc @ P['kv_ada_w'] + P['kv_ada_b'])[:, None, :]
            kv_shift, kv_scale = jnp.split(kv_mod, 2, axis=-1)
            hk = _modulate(_rms(x, P['kv_norm_g']), kv_shift, kv_scale)
            kv = hk @ P['kv_w']
            k_new = _rope(kv[..., :QK_W].reshape(B, T, N_HEADS_B, 2, HEAD_QK), pos)
            v_new = kv[..., QK_W:].reshape(B, T, N_HEADS_B, HEAD_V)
            if k_past is None:
                k_all, v_all = k_new.astype(F32), v_new.astype(F32)
            else:
                k_all = jnp.concatenate([k_past.astype(F32), k_new.astype(F32)], axis=1)
                v_all = jnp.concatenate([v_past.astype(F32), v_new.astype(F32)], axis=1)
            kpos = jnp.arange(past_len + T)
        mod = (sc @ P['ada_w'][l] + P['ada_b'][l])[:, None, :]
        s1, c1, g1, s2, c2, g2, s3, c3, g3 = jnp.split(mod, 9, axis=-1)
        ng = P['norm_g'][l]
        hf = _modulate(_rms(x, ng[0]), s1, c1)
        x = x + 0.5 * g1 * _rms(_swiglu(hf, P['ffn_w_in'][l, 0], P['ffn_w_out'][l, 0]), ng[1])
        hm = _modulate(_rms(x, ng[2]), s2, c2)
        if l < N_A:
            out, S_T, last = _rwkv7_time_mix(hm, shift_init[l], wkv_init[l], l, P)
            new_wkv.append(S_T)
            new_shift.append(last)
        else:
            out = _diff_attn_layer(hm, pos, k_all, v_all, kpos, l - N_A, l, P)
        x = x + g2 * _rms(out, ng[3])
        hf = _modulate(_rms(x, ng[4]), s3, c3)
        x = x + 0.5 * g3 * _rms(_swiglu(hf, P['ffn_w_in'][l, 1], P['ffn_w_out'][l, 1]), ng[5])
    return x, jnp.stack(new_wkv), jnp.stack(new_shift), k_new, v_new


def setup_inputs(seed: int = 0) -> dict:
    key = jax.random.key(seed)
    ks = iter(jax.random.split(key, 64))
    D = D_MODEL

    def nrm(shape, scale):
        return jax.random.normal(next(ks), shape, F32) * scale

    def unif(shape, lo, hi):
        return jax.random.uniform(next(ks), shape, F32, lo, hi)

    return {
        "x_prompt": nrm((BATCH, SEQ, D), 1.0),
        "x_sample": nrm((DEC_BATCH, DEC_SEQ, D), 1.0),
        "c_prompt": nrm((BATCH, D), 1.0),
        "c_sample": nrm((DEC_BATCH, D), 1.0),
        "state_wkv": nrm((N_A, DEC_BATCH, RWKV_HEADS, RWKV_HEAD, RWKV_HEAD), 0.5),
        "state_shift": nrm((N_A, DEC_BATCH, 1, D), 1.0),
        "cache_k": nrm((DEC_BATCH, PAST_LEN, N_HEADS_B, 2, HEAD_QK), 1.0),
        "cache_v": nrm((DEC_BATCH, PAST_LEN, N_HEADS_B, HEAD_V), 1.0),
        "ada_w": nrm((DEPTH, D, 9 * D), 0.5 * D ** -0.5),
        "ada_b": nrm((DEPTH, 9 * D), 0.02),
        "norm_g": 1.0 + nrm((DEPTH, 6, D), 0.05),
        "ffn_w_in": nrm((DEPTH, 2, D, 2 * D_FF), D ** -0.5),
        "ffn_w_out": nrm((DEPTH, 2, D_FF, D), D_FF ** -0.5),
        "rwkv_mu": unif((N_A, 6, D), 0.0, 1.0),
        "rwkv_w_rkv": nrm((N_A, 3, D, D), D ** -0.5),
        "rwkv_w0": unif((N_A, D), -6.0, -1.0),
        "rwkv_w1": nrm((N_A, D, DECAY_LORA), D ** -0.5),
        "rwkv_w2": nrm((N_A, DECAY_LORA, D), 0.5 * DECAY_LORA ** -0.5),
        "rwkv_a0": nrm((N_A, D), 0.1),
        "rwkv_a1": nrm((N_A, D, A_LORA), D ** -0.5),
        "rwkv_a2": nrm((N_A, A_LORA, D), 0.5 * A_LORA ** -0.5),
        "rwkv_g1": nrm((N_A, D, GATE_LORA), D ** -0.5),
        "rwkv_g2": nrm((N_A, GATE_LORA, D), GATE_LORA ** -0.5),
        "rwkv_k_k": 0.85 + nrm((N_A, D), 0.05),
        "rwkv_k_a": 1.0 + nrm((N_A, D), 0.05),
        "rwkv_r_k": nrm((N_A, RWKV_HEADS, RWKV_HEAD), 0.1),
        "rwkv_ln_w": 1.0 + nrm((N_A, D), 0.05),
        "rwkv_ln_b": nrm((N_A, D), 0.02),
        "rwkv_w_o": nrm((N_A, D, D), D ** -0.5),
        "kv_ada_w": nrm((D, 2 * D), 0.5 * D ** -0.5),
        "kv_ada_b": nrm((2 * D,), 0.02),
        "kv_norm_g": 1.0 + nrm((D,), 0.05),
        "kv_w": nrm((D, QK_W + V_W), D ** -0.5),
        "diff_w_q": nrm((N_B, D, QK_W), D ** -0.5),
        "diff_lambda": nrm((N_B, 4, HEAD_QK), 0.1),
        "diff_subln_g": 1.0 + nrm((N_B, HEAD_V), 0.05),
        "diff_w_o": nrm((N_B, V_W, D), V_W ** -0.5),
    }


def reference(x_prompt, x_sample, c_prompt, c_sample, state_wkv, state_shift, cache_k, cache_v,
              ada_w, ada_b, norm_g, ffn_w_in, ffn_w_out,
              rwkv_mu, rwkv_w_rkv, rwkv_w0, rwkv_w1, rwkv_w2, rwkv_a0, rwkv_a1, rwkv_a2,
              rwkv_g1, rwkv_g2, rwkv_k_k, rwkv_k_a, rwkv_r_k, rwkv_ln_w, rwkv_ln_b, rwkv_w_o,
              kv_ada_w, kv_ada_b, kv_norm_g, kv_w,
              diff_w_q, diff_lambda, diff_subln_g, diff_w_o):
    P = dict(ada_w=ada_w, ada_b=ada_b, norm_g=norm_g, ffn_w_in=ffn_w_in, ffn_w_out=ffn_w_out,
             rwkv_mu=rwkv_mu, rwkv_w_rkv=rwkv_w_rkv, rwkv_w0=rwkv_w0, rwkv_w1=rwkv_w1,
             rwkv_w2=rwkv_w2, rwkv_a0=rwkv_a0, rwkv_a1=rwkv_a1, rwkv_a2=rwkv_a2,
             rwkv_g1=rwkv_g1, rwkv_g2=rwkv_g2, rwkv_k_k=rwkv_k_k, rwkv_k_a=rwkv_k_a,
             rwkv_r_k=rwkv_r_k, rwkv_ln_w=rwkv_ln_w, rwkv_ln_b=rwkv_ln_b, rwkv_w_o=rwkv_w_o,
             kv_ada_w=kv_ada_w, kv_ada_b=kv_ada_b, kv_norm_g=kv_norm_g, kv_w=kv_w,
             diff_w_q=diff_w_q, diff_lambda=diff_lambda, diff_subln_g=diff_subln_g,
             diff_w_o=diff_w_o)
    Bp = x_prompt.shape[0]
    wkv0 = jnp.zeros((N_A, Bp, RWKV_HEADS, RWKV_HEAD, RWKV_HEAD), F32)
    shift0 = jnp.zeros((N_A, Bp, 1, D_MODEL), x_prompt.dtype)
    y_prompt, wkv_prompt, shift_prompt, k_prompt, v_prompt = _trunk(
        x_prompt, c_prompt, 0, wkv0, shift0, None, None, P)
    y_sample, wkv_sample, shift_sample, k_sample, v_sample = _trunk(
        x_sample, c_sample, PAST_LEN, state_wkv, state_shift, cache_k, cache_v, P)
    return (y_prompt, y_sample, wkv_prompt, shift_prompt, k_prompt, v_prompt,
            wkv_sample, shift_sample, k_sample, v_sample)
```

```cpp
#include <hip/hip_runtime.h>
#include <hip/hip_cooperative_groups.h>
#include <cstdio>
#include <cstdint>
__device__ __forceinline__ int opaque_tid() { int t = (int)threadIdx.x; asm volatile("" : "+v"(t)); return t; }
namespace pg8 {
#define PG8_LAS __attribute__((address_space(3)))
typedef unsigned short bf16_t;
typedef short bf16x8 __attribute__((ext_vector_type(8)));
typedef float f32x4 __attribute__((ext_vector_type(4)));
typedef unsigned u32x4 __attribute__((ext_vector_type(4)));
constexpr int BM = 256, BK = 64, HALF = 128, HTB = HALF * BK * 2  , STAGE_BYTES = 8 * HTB, NXCD = 8, WGM = 8;

__host__ __device__ __forceinline__ int lds_byte(int r, int c) { const int st = (r >> 4) * 2 + (c >> 5), rr = r & 15, cc = c & 31, ob = rr * 64 + cc * 2; return st * 1024 + (ob ^ (((ob >> 9) & 1) << 5)); }
__host__ __device__ __forceinline__ void stage_rc(int b, int& R, int& C) { const int st = b / 1024, sb = b % 1024, swz = sb ^ (((sb >> 9) & 1) << 5); R = (st >> 1) * 16 + swz / 64; C = (st & 1) * 32 + (swz % 64) / 2; }
__host__ __device__ __forceinline__ int perm32(int rho) { const int n = rho >> 4, i = rho & 15; return 8 * (i >> 2) + 4 * n + (i & 3); }

struct Unit { int pm, pn, kofs; };
struct Gemm { const bf16_t* A; const bf16_t* Bt; int M, N, K, ld; };

struct StaticOrder {
    static constexpr bool OPAQUE_K = false;
    int nM, nN, nwg, G, c;
    __host__ __device__ void init(int M, int N, int G_, int c_) { nM = M / BM; nN = N / BM; nwg = nM * nN; G = G_; c = c_; }
    __host__ __device__ bool next(int i, Unit& u) const {
        const long L = (long)i * G + c; if (L >= nwg) return false;
        int wgid = (int)L; { const int q = nwg / NXCD, r = nwg % NXCD, xcd = wgid % NXCD, off = wgid / NXCD; wgid = (xcd < r ? xcd * (q + 1) : r * (q + 1) + (xcd - r) * q) + off; }
        const int nig = WGM * nN, gid = wgid / nig, fm = gid * WGM, gsz = (nM - fm) < WGM ? (nM - fm) : WGM;
        u.pm = fm + ((wgid % nig) % gsz); u.pn = (wgid % nig) / gsz; u.kofs = 0; return true;
    }
    __device__ __forceinline__ void a_ready(const Unit&) const {}
    __device__ __forceinline__ void done(const Unit&) const {}
};

struct SplitOrder {
    static constexpr bool OPAQUE_K = true;
    int P, kpart, G, c;
    __host__ __device__ bool next(int i, Unit& u) const { const int L = i * G + c; if (L >= 16 * P) return false; const int kp = L >> 4, r = L & 15; u.pm = r >> 2; u.pn = r & 3; u.kofs = kp * kpart; return true; }
    __device__ __forceinline__ void a_ready(const Unit&) const {}
    __device__ __forceinline__ void done(const Unit&) const {}
};
__device__ __forceinline__ unsigned cvt_pk_bf16(float lo, float hi) { unsigned r; asm volatile("v_cvt_pk_bf16_f32 %0, %1, %2" : "=v"(r) : "v"(lo), "v"(hi)); return r; }
template <class Epi, class Sched, bool ALIGN_EPI = false, bool SP2 = false>
__device__ __forceinline__ void gemm_phase(PG8_LAS unsigned char* lds, const Gemm g, const Sched& S, const Epi& E) {
    const int tid = opaque_tid(), wid = __builtin_amdgcn_readfirstlane(tid >> 6), lane = tid & 63, wr = wid >> 2, wc = wid & 3, fr = lane & 15, fq = lane >> 4;
    int nt = g.K / BK; if constexpr (Sched::OPAQUE_K) asm volatile("" : "+s"(nt));
    const int K = g.ld;
    unsigned voffA[2], voffB[2];
#pragma unroll
    for (int i = 0; i < 2; ++i) { int R, C; stage_rc(tid * 16 + i * 8192, R, C); const int Rb = Epi::PERM ? ((R & ~31) + perm32(R & 31)) : R;
        voffA[i] = (unsigned)(R * K + C) * 2u; voffB[i] = (unsigned)(Rb * K + C) * 2u; }
    const size_t kstep = (size_t)(BK * 2);
    const size_t hstep = (size_t)HALF * K * 2;
    const size_t tstep = 2 * hstep;
    const unsigned ldsw = (unsigned)wid * 1024u;
    const int aoff = lds_byte(wr * 64 + fr, fq * 8), boff = lds_byte(wc * 32 + fr, fq * 8);
#define PG8_SA(b, h) (((b) * 2 + (h)) * HTB)
#define PG8_SB(b, h) ((4 + (b) * 2 + (h)) * HTB)
#define PG8_STAGE(bufoff, gbase, voff) do { _Pragma("unroll") for (int _i = 0; _i < 2; ++_i) \
        __builtin_amdgcn_global_load_lds((const unsigned*)((const char*)(gbase) + (voff)[_i]), (PG8_LAS unsigned*)(lds + (bufoff) + ldsw + _i * 8192), 16, 0, 0); } while (0)
#define PG8_LDA(dst, b, h) do { _Pragma("unroll") for (int m = 0; m < 4; ++m) _Pragma("unroll") for (int k = 0; k < 2; ++k) dst[m][k] = *(const PG8_LAS bf16x8*)(lds + PG8_SA(b, h) + aoff + m * 2048 + k * 1024); } while (0)
#define PG8_LDB(dst, b, h) do { _Pragma("unroll") for (int n = 0; n < 2; ++n) _Pragma("unroll") for (int k = 0; k < 2; ++k) dst[n][k] = *(const PG8_LAS bf16x8*)(lds + PG8_SB(b, h) + boff + n * 2048 + k * 1024); } while (0)
#define PG8_MMA(ai, bj, At, Bt) do { __builtin_amdgcn_s_setprio(1); _Pragma("unroll") for (int m = 0; m < 4; ++m) _Pragma("unroll") for (int n = 0; n < 2; ++n) _Pragma("unroll") for (int k = 0; k < 2; ++k) \
        acc[ai][bj][m][n] = __builtin_amdgcn_mfma_f32_16x16x32_bf16(Bt[n][k], At[m][k], acc[ai][bj][m][n], 0, 0, 0); __builtin_amdgcn_s_setprio(0); } while (0)
#define PG8_WAIT_V(n) asm volatile("s_waitcnt vmcnt(" #n ")" ::: "memory")
#define PG8_WAIT_L(n) asm volatile("s_waitcnt lgkmcnt(" #n ")" ::: "memory")
#define PG8_BAR __builtin_amdgcn_s_barrier()
#define PG8_SCHED __builtin_amdgcn_sched_barrier(0)
    Unit cur, nxt; int ui = 0;
    if (!S.next(0, cur)) return;
    f32x4 acc[2][2][4][2];
#pragma unroll
    for (int a = 0; a < 2; ++a)
#pragma unroll
        for (int b = 0; b < 2; ++b)
#pragma unroll
            for (int m = 0; m < 4; ++m)
#pragma unroll
                for (int n = 0; n < 2; ++n) acc[a][b][m][n] = (f32x4){0.f, 0.f, 0.f, 0.f};
    bf16x8 At[4][2], B0[2][2], B1[2][2];
    const char* cA = (const char*)g.A + (size_t)cur.pm * tstep + (size_t)cur.kofs * 2; const char* cB = (const char*)g.Bt + (size_t)cur.pn * tstep + (size_t)cur.kofs * 2;
    S.a_ready(cur);
    if constexpr (SP2) {
        PG8_STAGE(PG8_SB(0, 0), cB, voffB); PG8_STAGE(PG8_SB(0, 1), cB + hstep, voffB); PG8_STAGE(PG8_SA(0, 0), cA, voffA); PG8_STAGE(PG8_SA(0, 1), cA + hstep, voffA);
        if (wr == 1) PG8_BAR;
        PG8_WAIT_V(2); PG8_BAR;
        PG8_STAGE(PG8_SB(1, 0), cB + kstep, voffB); PG8_STAGE(PG8_SA(1, 0), cA + kstep, voffA); PG8_STAGE(PG8_SB(1, 1), cB + hstep + kstep, voffB);
        PG8_WAIT_V(6); PG8_BAR;
    } else {
        PG8_STAGE(PG8_SB(0, 0), cB, voffB); PG8_STAGE(PG8_SA(0, 0), cA, voffA); PG8_STAGE(PG8_SB(0, 1), cB + hstep, voffB); PG8_STAGE(PG8_SA(0, 1), cA + hstep, voffA);
        if (wr == 1) PG8_BAR;
        PG8_WAIT_V(4); PG8_BAR;
        PG8_STAGE(PG8_SB(1, 0), cB + kstep, voffB); PG8_STAGE(PG8_SA(1, 0), cA + kstep, voffA); PG8_STAGE(PG8_SB(1, 1), cB + hstep + kstep, voffB);
        PG8_WAIT_V(6); PG8_BAR;
    }
    for (;;) {
        const bool has_next = S.next(ui + 1, nxt);
        const char* nA = has_next ? (const char*)g.A + (size_t)nxt.pm * tstep + (size_t)nxt.kofs * 2 : cA; const char* nB = has_next ? (const char*)g.Bt + (size_t)nxt.pn * tstep + (size_t)nxt.kofs * 2 : cB;
        for (int t = 0; t < nt; t += 2) {
            const bool last = (t == nt - 2);
            const char* a1 = cA + (size_t)(t + 1) * kstep;
            const char* a2 = last ? nA : cA + (size_t)(t + 2) * kstep; const char* b2 = last ? nB : cB + (size_t)(t + 2) * kstep;
            const char* a3 = a2 + kstep; const char* b3 = b2 + kstep;
            if (last && has_next) S.a_ready(nxt);
            if constexpr (SP2) {
            PG8_LDB(B0, 0, 0); PG8_LDB(B1, 0, 1); PG8_SCHED; PG8_LDA(At, 0, 0); PG8_STAGE(PG8_SA(1, 1), a1 + hstep, voffA);
            PG8_WAIT_V(8); PG8_WAIT_L(0); PG8_BAR; PG8_MMA(0, 0, At, B0); PG8_MMA(0, 1, At, B1); PG8_BAR; PG8_SCHED;
            PG8_LDA(At, 0, 1); PG8_STAGE(PG8_SB(0, 0), b2, voffB); PG8_STAGE(PG8_SB(0, 1), b2 + hstep, voffB); PG8_STAGE(PG8_SA(0, 0), a2, voffA);
            PG8_WAIT_V(8); PG8_WAIT_L(0); PG8_BAR; PG8_MMA(1, 0, At, B0); PG8_MMA(1, 1, At, B1); PG8_BAR; PG8_SCHED;
            PG8_LDB(B0, 1, 0); PG8_LDB(B1, 1, 1); PG8_SCHED; PG8_LDA(At, 1, 0); PG8_STAGE(PG8_SA(0, 1), a2 + hstep, voffA);
            PG8_WAIT_V(8); PG8_WAIT_L(0); PG8_BAR; PG8_MMA(0, 0, At, B0); PG8_MMA(0, 1, At, B1); PG8_BAR; PG8_SCHED;
            PG8_LDA(At, 1, 1); PG8_STAGE(PG8_SB(1, 0), b3, voffB); PG8_STAGE(PG8_SB(1, 1), b3 + hstep, voffB); PG8_STAGE(PG8_SA(1, 0), a3, voffA);
            PG8_WAIT_V(8); PG8_WAIT_L(0); PG8_BAR; PG8_MMA(1, 0, At, B0); PG8_MMA(1, 1, At, B1); PG8_BAR; PG8_SCHED;
            } else {
            PG8_LDB(B0, 0, 0); PG8_SCHED; PG8_LDA(At, 0, 0); PG8_STAGE(PG8_SA(1, 1), a1 + hstep, voffA);
            PG8_WAIT_L(8); PG8_BAR; PG8_WAIT_L(0); PG8_MMA(0, 0, At, B0); PG8_BAR; PG8_SCHED;
            PG8_LDB(B1, 0, 1); PG8_STAGE(PG8_SB(0, 0), b2, voffB);
            PG8_BAR; PG8_WAIT_L(0); PG8_MMA(0, 1, At, B1); PG8_BAR;
            PG8_LDA(At, 0, 1); PG8_STAGE(PG8_SA(0, 0), a2, voffA);
            PG8_BAR; PG8_WAIT_L(0); PG8_MMA(1, 0, At, B0); PG8_BAR; PG8_SCHED;
            PG8_STAGE(PG8_SB(0, 1), b2 + hstep, voffB);
            PG8_WAIT_V(6); PG8_BAR; PG8_MMA(1, 1, At, B1); PG8_BAR;
            PG8_LDB(B0, 1, 0); PG8_SCHED; PG8_LDA(At, 1, 0); PG8_STAGE(PG8_SA(0, 1), a2 + hstep, voffA);
            PG8_WAIT_L(8); PG8_BAR; PG8_WAIT_L(0); PG8_MMA(0, 0, At, B0); PG8_BAR; PG8_SCHED;
            PG8_LDB(B1, 1, 1); PG8_STAGE(PG8_SB(1, 0), b3, voffB);
            PG8_BAR; PG8_WAIT_L(0); PG8_MMA(0, 1, At, B1); PG8_BAR;
            PG8_LDA(At, 1, 1); PG8_STAGE(PG8_SA(1, 0), a3, voffA);
            PG8_BAR; PG8_WAIT_L(0); PG8_MMA(1, 0, At, B0); PG8_BAR; PG8_SCHED;
            PG8_STAGE(PG8_SB(1, 1), b3 + hstep, voffB);
            PG8_WAIT_V(6); PG8_BAR; PG8_MMA(1, 1, At, B1); PG8_BAR;
            }
        }
        if constexpr (ALIGN_EPI) { if (wr == 0) PG8_BAR; }
        if constexpr (!Epi::AFTER_DRAIN) { E(acc, cur, wr, wc, fr, fq); S.done(cur); }
        if (!has_next) break;
#pragma unroll
        for (int a = 0; a < 2; ++a)
#pragma unroll
            for (int b = 0; b < 2; ++b)
#pragma unroll
                for (int m = 0; m < 4; ++m)
#pragma unroll
                    for (int n = 0; n < 2; ++n) acc[a][b][m][n] = (f32x4){0.f, 0.f, 0.f, 0.f};
        cur = nxt; cA = nA; cB = nB; ++ui;
        if constexpr (ALIGN_EPI) { if (wr == 1) PG8_BAR; }
    }
    PG8_WAIT_V(0);
    if constexpr (!ALIGN_EPI) { if (wr == 0) PG8_BAR; }
    PG8_BAR;
    if constexpr (Epi::AFTER_DRAIN) { E.fused(acc, cur, wr, wc, fr, fq, lds, wid, lane); S.done(cur); }
#undef PG8_SA
#undef PG8_SB
#undef PG8_STAGE
#undef PG8_LDA
#undef PG8_LDB
#undef PG8_MMA
#undef PG8_WAIT_V
#undef PG8_WAIT_L
#undef PG8_BAR
#undef PG8_SCHED
}
}
#include <hip/hip_bf16.h>
#include <cmath>
namespace attn_body {
using bf16=__hip_bfloat16;
using bf16x8=__attribute__((ext_vector_type(8)))short;
using s16x4=__attribute__((ext_vector_type(4)))short;
using f32x16=__attribute__((ext_vector_type(16)))float;
using u32x4=__attribute__((ext_vector_type(4)))unsigned;
constexpr int BATCH=2,NHEAD=16,SEQ=8192,D=64,DM=NHEAD*D;
constexpr int NW=8,QBLK=32,QB=QBLK*NW,KVBLK=64,NQB=SEQ/QB;
constexpr int ATTN_PITCH=DM, ATTN_UNIT_ROWS=QB;
__device__ __forceinline__ int crow(int r,int hi){return (r&3)+8*(r>>2)+4*hi;}
#define SBAR() __builtin_amdgcn_sched_barrier(0)
__device__ __forceinline__ void cmask(f32x16&p0,f32x16&p1,int jb,int qrel,int hi){
  const float NEG=-INFINITY; (void)hi;
  if(jb>(qrel>>6)){
  #pragma unroll
  for(int r=0;r<16;++r){p0[r]=NEG;p1[r]=NEG;} }
}

constexpr int NSLOT=3, SLOTB=8192;
constexpr int LDS_K=0, LDS_V=NSLOT*SLOTB, LDS_WS=2*NSLOT*SLOTB, LDS_OST=LDS_WS+NW*64*4, LDS_BYTES=LDS_OST+NW*4096;
constexpr float C2=0.125f*1.4426950408889634f;
__device__ __forceinline__ void glds16(const void*gsrc,unsigned lds_dst){unsigned keep;
  asm volatile("s_mov_b32 %0, m0\n\ts_mov_b32 m0, %2\n\ts_nop 0\n\tglobal_load_lds_dwordx4 %1, off\n\ts_mov_b32 m0, %0":"=&s"(keep):"v"(gsrc),"s"(lds_dst):"memory");}
__device__ __forceinline__ float max3f(float a,float b,float c){float r;asm("v_max3_f32 %0, %1, %2, %3":"=v"(r):"v"(a),"v"(b),"v"(c));return r;}
__device__ __forceinline__ float max2f(float a,float b){float r;asm("v_max_f32_e32 %0, %1, %2":"=v"(r):"v"(a),"v"(b));return r;}
__device__ __forceinline__ float fadd_s(float a,float b){float r;asm("v_add_f32_e32 %0, %1, %2":"=v"(r):"v"(a),"v"(b));return r;}
__device__ __forceinline__ float fsub_s(float a,float b){float r;asm("v_sub_f32_e32 %0, %1, %2":"=v"(r):"v"(a),"v"(b));return r;}
typedef float f32x2_t __attribute__((ext_vector_type(2))); typedef __bf16 bf16x2_t __attribute__((ext_vector_type(2)));
__device__ __forceinline__ unsigned cvtpk_s(float lo,float hi){f32x2_t v={lo,hi};bf16x2_t b=__builtin_convertvector(v,bf16x2_t);return __builtin_bit_cast(unsigned,b);}
#define WAIT_BAR(N) asm volatile("s_waitcnt vmcnt(" #N ") lgkmcnt(0)\n\ts_barrier":::"memory")

__device__ __forceinline__ void qkt(f32x16&p0,f32x16&p1,const char*Kslot,const bf16x8*qr,const f32x16&negm,int r32,int hi){
  const char*kb=Kslot+hi*1024+r32*16;
  #pragma unroll
  for(int d0=0;d0<4;++d0){
    const bf16x8 b0=*reinterpret_cast<const bf16x8*>(kb+d0*2048);
    const bf16x8 b1=*reinterpret_cast<const bf16x8*>(kb+d0*2048+512);
    if(d0==0){p0=__builtin_amdgcn_mfma_f32_32x32x16_bf16(b0,qr[0],negm,0,0,0);p1=__builtin_amdgcn_mfma_f32_32x32x16_bf16(b1,qr[0],negm,0,0,0);}
    else{p0=__builtin_amdgcn_mfma_f32_32x32x16_bf16(b0,qr[d0],p0,0,0,0);p1=__builtin_amdgcn_mfma_f32_32x32x16_bf16(b1,qr[d0],p1,0,0,0);}}
}
typedef __attribute__((address_space(3))) const char* lds_cptr;
typedef short v4i16_t __attribute__((ext_vector_type(4)));
__device__ __forceinline__ void kload8(bf16x8*kf,lds_cptr kp){
  kf[0]=*(const __attribute__((address_space(3))) bf16x8*)(kp);      kf[1]=*(const __attribute__((address_space(3))) bf16x8*)(kp+512);
  kf[2]=*(const __attribute__((address_space(3))) bf16x8*)(kp+2048); kf[3]=*(const __attribute__((address_space(3))) bf16x8*)(kp+2560);
  kf[4]=*(const __attribute__((address_space(3))) bf16x8*)(kp+4096); kf[5]=*(const __attribute__((address_space(3))) bf16x8*)(kp+4608);
  kf[6]=*(const __attribute__((address_space(3))) bf16x8*)(kp+6144); kf[7]=*(const __attribute__((address_space(3))) bf16x8*)(kp+6656);
}
__device__ __forceinline__ void kload2(bf16x8*kf,lds_cptr kp,int j){ kf[2*j]=*(const __attribute__((address_space(3))) bf16x8*)(kp+j*2048); kf[2*j+1]=*(const __attribute__((address_space(3))) bf16x8*)(kp+j*2048+512); }
__device__ __forceinline__ s16x4 vtr(lds_cptr p){ return __builtin_bit_cast(s16x4,__builtin_amdgcn_ds_read_tr16_b64_v4i16((__attribute__((address_space(3))) v4i16_t*)p)); }
__device__ __forceinline__ float rowmax(const f32x16&p0,const f32x16&p1){
  float a=max3f(p0[0],p0[1],p1[0]),b=max3f(p0[2],p0[3],p1[1]);a=max3f(a,p1[2],p1[3]);
  #pragma unroll
  for(int r=4;r<16;r+=4){a=max3f(a,p0[r],p0[r+1]);b=max3f(b,p0[r+2],p0[r+3]);a=max3f(a,p1[r],p1[r+1]);b=max3f(b,p1[r+2],p1[r+3]);}
  const float m=max2f(a,b);
  auto rr=__builtin_amdgcn_permlane32_swap(__float_as_uint(m),__float_as_uint(m),false,false);
  return max2f(__uint_as_float(rr[0]),__uint_as_float(rr[1]));
}
__device__ __forceinline__ void pv(f32x16*o,int vb,bf16x8 pa0,bf16x8 pa1,bf16x8 pa2,bf16x8 pa3){
  #pragma unroll
  for(int d0=0;d0<2;++d0){s16x4 lo[4],hi[4];
    #pragma unroll
    for(int ks=0;ks<4;++ks){
      asm volatile("ds_read_b64_tr_b16 %0,%1 offset:%c2":"=&v"(lo[ks]):"v"(vb),"i"(d0*4096+ks*1024):"memory");
      asm volatile("ds_read_b64_tr_b16 %0,%1 offset:%c2":"=&v"(hi[ks]):"v"(vb),"i"(d0*4096+ks*1024+512):"memory");}
    asm volatile("s_waitcnt lgkmcnt(0)":::"memory");SBAR();
    #define PK(k) (bf16x8){lo[k][0],lo[k][1],lo[k][2],lo[k][3],hi[k][0],hi[k][1],hi[k][2],hi[k][3]}
    o[d0]=__builtin_amdgcn_mfma_f32_32x32x16_bf16(pa0,PK(0),o[d0],0,0,0);
    o[d0]=__builtin_amdgcn_mfma_f32_32x32x16_bf16(pa1,PK(1),o[d0],0,0,0);
    o[d0]=__builtin_amdgcn_mfma_f32_32x32x16_bf16(pa2,PK(2),o[d0],0,0,0);
    o[d0]=__builtin_amdgcn_mfma_f32_32x32x16_bf16(pa3,PK(3),o[d0],0,0,0);
    #undef PK
  }
}

#ifndef ATTN_STORE16
#define ATTN_STORE16(p,v) (*(u32x4*)(p)=(v))
#endif
constexpr int OPITCH=2048;
template<int THRL,bool SMP> __device__ __forceinline__ void attn_unit(const bf16*Qu,const bf16*__restrict__ Kh,const bf16*__restrict__ Vh,bf16*Ou,const int NT,char*shm){
  const int tid=opaque_tid(),lane=tid&63,r32=lane&31,hi=lane>>5; const int wid=__builtin_amdgcn_readfirstlane(tid>>6);
  const bf16*Qw=Qu+(long)(wid*QBLK)*DM;
  const unsigned lds0=(unsigned)(uintptr_t)shm;
  float*wsf=(float*)(shm+LDS_WS)+wid*64;
  const bf16*ksrc=Kh+(long)lane*DM+wid*8;
  const bf16*vsrc=Vh+(long)(16*(wid&3)+(lane>>2))*DM+(wid>>2)*32+(lane&3)*8;
  const unsigned kdst=lds0+LDS_K+wid*1024, vdst=lds0+LDS_V+wid*1024;
  #define DMA_K(t,slot) glds16(ksrc+(long)(t)*KVBLK*DM,(unsigned)__builtin_amdgcn_readfirstlane(kdst+(slot)))
  #define DMA_V(t,slot) glds16(vsrc+(long)(t)*KVBLK*DM,(unsigned)__builtin_amdgcn_readfirstlane(vdst+(slot)))
  const int vb0=(int)(lds0+LDS_V)+((lane>>4)&1)*32+(lane&3)*8+(4*hi+((lane&15)>>2))*64;
  const char*Kbase=shm+LDS_K; bf16x8 kf[8];
  const lds_cptr shm3=(lds_cptr)shm; const lds_cptr kp0=shm3+LDS_K+hi*1024+r32*16; const lds_cptr vp0=shm3+LDS_V+((lane>>4)&1)*32+(lane&3)*8+(4*hi+((lane&15)>>2))*64;
  if(SMP&&!(wid==4||wid==5)){
    int sp_=0,sc_=0,sn_=SLOTB; (void)sp_;
    #define ROTS() do{sp_=sc_;sc_=sn_;sn_=(sn_==(NSLOT-1)*SLOTB)?0:sn_+SLOTB;}while(0)
    #define SKS(t,GK,GV) do{ if(GK){DMA_K((t)+3,sc_);} if(GV){DMA_V((t)+1,sn_);} }while(0)
    #define ENDS(tt) do{ if((tt)+3<NT){WAIT_BAR(2);} else if((tt)+2<NT){WAIT_BAR(1);} else {WAIT_BAR(0);} }while(0)
    DMA_K(0,0);DMA_V(0,0);DMA_K(1,SLOTB);
    DMA_K(2,2*SLOTB);
    WAIT_BAR(3);
    WAIT_BAR(0);
    DMA_K(3,0);DMA_V(1,SLOTB);
    ROTS();
    WAIT_BAR(2);
    int t=1;
    for(;t+5<NT;t+=2){ SKS(t,true,true); WAIT_BAR(2); ROTS(); SKS(t+1,true,true); WAIT_BAR(2); ROTS(); }
    for(;t+1<NT;t+=2){ SKS(t,(t+3<NT),(t+1<NT)); ENDS(t); ROTS(); SKS(t+1,(t+4<NT),(t+2<NT)); ENDS(t+1); ROTS(); }
    asm volatile("s_waitcnt lgkmcnt(0)\n\ts_barrier":::"memory");
    #undef ROTS
    #undef SKS
    #undef ENDS
    return;
  }
  DMA_K(0,0);DMA_V(0,0);DMA_K(1,SLOTB);
  bf16x8 qr[4];
  #pragma unroll
  for(int d0=0;d0<4;++d0)qr[d0]=*reinterpret_cast<const bf16x8*>(&Qw[(long)r32*DM+d0*16+hi*8]);
  float mhat=0.f,l_reg=0.f;f32x16 o[2];o[0]=f32x16{};o[1]=f32x16{};f32x16 negm=f32x16{};asm volatile("":"+v"(negm));
  const int qrel=wid*QBLK+r32;
  #define CMASK(P0,P1,t) do{int jb_=(t)-(NT-4); if(jb_>=0)cmask(P0,P1,jb_,qrel,hi);}while(0)
  bool resc=false;
  #define START(P0,P1) do{ const float rm=rowmax(P0,P1); resc=false; \
    { const float dl=rm; mhat=fadd_s(mhat,dl); \
      _Pragma("unroll") for(int r=0;r<16;++r){P0[r]=fsub_s(P0[r],dl);P1[r]=fsub_s(P1[r],dl);} \
      _Pragma("unroll") for(int r=0;r<16;++r)negm[r]=-mhat; asm volatile("":"+v"(negm)); } \
    _Pragma("unroll") for(int r=0;r<16;++r)P0[r]=__builtin_amdgcn_exp2f(P0[r]); }while(0)
  #define RESC() do{ if(resc){ asm volatile("s_waitcnt lgkmcnt(0)":::"memory"); \
      _Pragma("unroll") for(int d_=0;d_<2;++d_) _Pragma("unroll") for(int r=0;r<16;++r)o[d_][r]*=wsf[crow(r,hi)]; } }while(0)
  f32x16 pA0,pA1,pB0,pB1;
  int sl_prev=0,sl_cur=0,sl_next=SLOTB;
  #define ROT() do{sl_prev=sl_cur;sl_cur=sl_next;sl_next=(sl_next==(NSLOT-1)*SLOTB)?0:sl_next+SLOTB;}while(0)
  DMA_K(2,2*SLOTB);
  WAIT_BAR(3);
  qkt(pA0,pA1,Kbase,qr,negm,r32,hi);asm volatile("s_nop 15\n\ts_nop 7":"+v"(pA0),"+v"(pA1));CMASK(pA0,pA1,0);
  START(pA0,pA1);
  _Pragma("unroll") for(int r=0;r<16;++r)pA1[r]=__builtin_amdgcn_exp2f(pA1[r]);
  WAIT_BAR(0);
  DMA_K(3,0);DMA_V(1,SLOTB);
  ROT();
  kload8(kf,kp0+sl_cur);
  WAIT_BAR(2);
  s16x4 vlo[8],vhi[8]; u32x4 pw0,pw1,pw2,pw3;
  #define PKW(P,B) cvtpk_s(P[B],P[B+1])
  #define PAF(k) __builtin_bit_cast(bf16x8,pw##k)
  #define VFR(i) (bf16x8){vlo[i][0],vlo[i][1],vlo[i][2],vlo[i][3],vhi[i][0],vhi[i][1],vhi[i][2],vhi[i][3]}
  #define PIN(x) asm volatile("":"+v"(x))
  #define MX3(a,b,c) __builtin_fmaxf(__builtin_fmaxf((a),(b)),(c))
  #define GAPA(MF,A0,A1,A2,A3,W0,W1,PW) do{ MF; sacc+=A0; sacc+=A1; sacc+=A2; sacc+=A3; PIN(sacc); W0; W1; PIN(PW); SBAR(); }while(0)
  #define EX(v) __builtin_amdgcn_exp2f(v)
  #define GAPB(MF,X,B) do{ MF; X[B]=EX(X[B]); X[B+1]=EX(X[B+1]); X[B+2]=EX(X[B+2]); X[B+3]=EX(X[B+3]); PIN(X); SBAR(); }while(0)
  #define VRD(i) do{ vlo[i]=vtr(vp_+(((i)>>2)*4096+((i)&3)*1024)); vhi[i]=vtr(vp_+(((i)>>2)*4096+((i)&3)*1024+512)); }while(0)
  #define KRD(G,j) do{ if(G){ kload2(kf,kp0+sl_next,j); SBAR(); } }while(0)
  #define STEP(C0,C1,P0,P1,t,GK,GV,GL) do{ SBAR(); \
    const lds_cptr vp_=vp0+sl_prev; \
    VRD(0); SBAR(); float sacc=(P0[0]+P0[1]); \
    GAPA(C0=__builtin_amdgcn_mfma_f32_32x32x16_bf16(kf[0],qr[0],negm,0,0,0), P0[2],P0[3],P0[4],P0[5],     pw0[0]=PKW(P0,0), pw0[1]=PKW(P0,2), pw0); \
    VRD(4); SBAR(); GAPA(C1=__builtin_amdgcn_mfma_f32_32x32x16_bf16(kf[1],qr[0],negm,0,0,0), P0[6],P0[7],P0[8],P0[9],     pw0[2]=PKW(P0,4), pw0[3]=PKW(P0,6), pw0); \
    VRD(1); SBAR(); GAPA(C0=__builtin_amdgcn_mfma_f32_32x32x16_bf16(kf[2],qr[1],C0,0,0,0),   P0[10],P0[11],P0[12],P0[13], pw1[0]=PKW(P0,8), pw1[1]=PKW(P0,10), pw1); \
    VRD(5); SBAR(); GAPA(C1=__builtin_amdgcn_mfma_f32_32x32x16_bf16(kf[3],qr[1],C1,0,0,0),   P0[14],P0[15],P1[0],P1[1],   pw1[2]=PKW(P0,12),pw1[3]=PKW(P0,14), pw1); \
    VRD(2); SBAR(); GAPA(C0=__builtin_amdgcn_mfma_f32_32x32x16_bf16(kf[4],qr[2],C0,0,0,0),   P1[2],P1[3],P1[4],P1[5],     pw2[0]=PKW(P1,0), pw2[1]=PKW(P1,2), pw2); \
    VRD(6); SBAR(); GAPA(C1=__builtin_amdgcn_mfma_f32_32x32x16_bf16(kf[5],qr[2],C1,0,0,0),   P1[6],P1[7],P1[8],P1[9],     pw2[2]=PKW(P1,4), pw2[3]=PKW(P1,6), pw2); \
    VRD(3); SBAR(); GAPA(C0=__builtin_amdgcn_mfma_f32_32x32x16_bf16(kf[6],qr[3],C0,0,0,0),   P1[10],P1[11],P1[12],P1[13], pw3[0]=PKW(P1,8), pw3[1]=PKW(P1,10), pw3); \
    VRD(7); SBAR(); GAPA(C1=__builtin_amdgcn_mfma_f32_32x32x16_bf16(kf[7],qr[3],C1,0,0,0),   P1[14],P1[15],0.f,0.f,       pw3[2]=PKW(P1,12),pw3[3]=PKW(P1,14), pw3); \
    l_reg+=sacc; \
    if(GK){DMA_K((t)+3,sl_cur);} if(GV){DMA_V((t)+1,sl_next);} \
    CMASK(C0,C1,t); \
    { float a=MX3(C0[0],C0[1],C1[0]),b=MX3(C0[2],C0[3],C1[1]); a=MX3(a,C1[2],C1[3]); \
      _Pragma("unroll") for(int r=4;r<16;r+=4){a=MX3(a,C0[r],C0[r+1]);b=MX3(b,C0[r+2],C0[r+3]);a=MX3(a,C1[r],C1[r+1]);b=MX3(b,C1[r+2],C1[r+3]);} \
      float rm=__builtin_fmaxf(a,b); { auto rr=__builtin_amdgcn_permlane32_swap(__float_as_uint(rm),__float_as_uint(rm),false,false); rm=__builtin_fmaxf(__uint_as_float(rr[0]),__uint_as_float(rr[1])); } \
      resc=false; \
      if(__builtin_expect(__any(rm>(float)THRL),0)){ const float dl=__builtin_fmaxf(rm,0.f); mhat+=dl; \
        _Pragma("unroll") for(int r=0;r<16;++r){C0[r]-=dl;C1[r]-=dl;} \
        _Pragma("unroll") for(int r=0;r<16;++r)negm[r]=-mhat; asm volatile("":"+v"(negm)); \
        const float f=__builtin_amdgcn_exp2f(-dl); l_reg*=f; if(hi==0)wsf[r32]=f; resc=true; } } \
    SBAR(); \
    GAPB(o[0]=__builtin_amdgcn_mfma_f32_32x32x16_bf16(PAF(0),VFR(0),o[0],0,0,0), C0,0); \
    GAPB(o[1]=__builtin_amdgcn_mfma_f32_32x32x16_bf16(PAF(0),VFR(4),o[1],0,0,0), C0,4); \
    KRD(GL,0); GAPB(o[0]=__builtin_amdgcn_mfma_f32_32x32x16_bf16(PAF(1),VFR(1),o[0],0,0,0), C0,8); \
    KRD(GL,1); GAPB(o[1]=__builtin_amdgcn_mfma_f32_32x32x16_bf16(PAF(1),VFR(5),o[1],0,0,0), C0,12); \
    KRD(GL,2); GAPB(o[0]=__builtin_amdgcn_mfma_f32_32x32x16_bf16(PAF(2),VFR(2),o[0],0,0,0), C1,0); \
    KRD(GL,3); GAPB(o[1]=__builtin_amdgcn_mfma_f32_32x32x16_bf16(PAF(2),VFR(6),o[1],0,0,0), C1,4); \
    GAPB(o[0]=__builtin_amdgcn_mfma_f32_32x32x16_bf16(PAF(3),VFR(3),o[0],0,0,0), C1,8); \
    GAPB(o[1]=__builtin_amdgcn_mfma_f32_32x32x16_bf16(PAF(3),VFR(7),o[1],0,0,0), C1,12); \
    }while(0)
  int t=1;
  #undef CMASK
  #define CMASK(P0,P1,t) do{}while(0)
  for(;t+5<NT;t+=2){
    STEP(pB0,pB1,pA0,pA1,t,true,true,true);     WAIT_BAR(2); RESC(); ROT();
    STEP(pA0,pA1,pB0,pB1,t+1,true,true,true);   WAIT_BAR(2); RESC(); ROT();
  }
  #undef CMASK
  #define CMASK(P0,P1,t) do{int jb_=(t)-(NT-4); if(jb_>=0)cmask(P0,P1,jb_,qrel,hi);}while(0)
  #define ENDW(tt) do{ if((tt)+3<NT){WAIT_BAR(2);} else if((tt)+2<NT){WAIT_BAR(1);} else {WAIT_BAR(0);} }while(0)
  for(;t+1<NT;t+=2){
    STEP(pB0,pB1,pA0,pA1,t,(t+3<NT),(t+1<NT),(t+1<NT));       ENDW(t);   RESC(); ROT();
    STEP(pA0,pA1,pB0,pB1,t+1,(t+4<NT),(t+2<NT),(t+2<NT));     ENDW(t+1); RESC(); ROT();
  }
  STEP(pB0,pB1,pA0,pA1,NT-1,false,false,false); RESC();
  { float sacc=pB0[0]+pB0[1]; _Pragma("unroll") for(int r=2;r<16;++r)sacc+=pB0[r]; _Pragma("unroll") for(int r=0;r<16;++r)sacc+=pB1[r]; l_reg+=sacc;
    pw0=(u32x4){PKW(pB0,0),PKW(pB0,2),PKW(pB0,4),PKW(pB0,6)};pw1=(u32x4){PKW(pB0,8),PKW(pB0,10),PKW(pB0,12),PKW(pB0,14)};pw2=(u32x4){PKW(pB1,0),PKW(pB1,2),PKW(pB1,4),PKW(pB1,6)};pw3=(u32x4){PKW(pB1,8),PKW(pB1,10),PKW(pB1,12),PKW(pB1,14)};
    SBAR(); pv(o,vb0+sl_cur,PAF(0),PAF(1),PAF(2),PAF(3)); }
  #undef PKW
  #undef PAF
  #undef VFR
  #undef PIN
  #undef MX3
  #undef GAPA
  #undef GAPB
  #undef EX
  #undef VRD
  #undef KRD
  #undef STEP
  #undef ENDW
  {auto rr=__builtin_amdgcn_permlane32_swap(__float_as_uint(l_reg),__float_as_uint(l_reg),false,false);l_reg=__uint_as_float(rr[0])+__uint_as_float(rr[1]);}
  if(hi==0)wsf[32+r32]=l_reg;asm volatile("s_waitcnt lgkmcnt(0)":::"memory");
  float rli[16];
  #pragma unroll
  for(int r=0;r<16;++r)rli[r]=__builtin_amdgcn_rcpf(wsf[32+crow(r,hi)]);
  bf16*Ow=Ou+(long)(wid*QBLK)*OPITCH;
  { bf16*stg=(bf16*)(shm+LDS_OST)+wid*2048;
    #pragma unroll
    for(int r=0;r<16;++r){const int orow=crow(r,hi);
      #pragma unroll
      for(int d0=0;d0<2;++d0)stg[orow*64+d0*32+r32]=__float2bfloat16(o[d0][r]*rli[r]);}
    asm volatile("s_waitcnt lgkmcnt(0)":::"memory");
    #pragma unroll
    for(int i=0;i<4;++i){const int row=i*8+(lane>>3),ch=lane&7; const u32x4 v=*(const u32x4*)(stg+row*64+ch*8); ATTN_STORE16(Ow+(long)row*OPITCH+ch*8,v);} }
  asm volatile("s_waitcnt lgkmcnt(0)\n\ts_barrier":::"memory");
  #undef DMA_K
  #undef DMA_V
  #undef CMASK
  #undef START
  #undef RESC
  #undef ROT
}
constexpr int ATTN_LDS_BYTES=LDS_BYTES;
#undef SBAR
#undef WAIT_BAR
}


#ifndef EN_P0
#define EN_P0 1
#endif
#ifndef EN_SCAN
#define EN_SCAN 1
#endif
#ifndef EN_POST
#define EN_POST 1
#endif
#ifndef EN_ATTN
#define EN_ATTN 1
#endif
#ifndef EN_COMB
#define EN_COMB 1
#endif
#ifndef EN_GEMM
#define EN_GEMM 1
#endif
#ifndef EN_RP
#define EN_RP 1
#endif
#define GAS __attribute__((address_space(1)))
#define LAS __attribute__((address_space(3)))
typedef unsigned short bf16;
typedef unsigned v4u __attribute__((ext_vector_type(4)));
typedef unsigned v2u __attribute__((ext_vector_type(2)));
typedef float f32x4 __attribute__((ext_vector_type(4)));
namespace cg = cooperative_groups;

constexpr int NWAVES = 8;
constexpr int D = 1024, NP = 16384, NS = 1024, NTOK = NP + NS, NSEQ = 18, DFF = 2816, PAST = 2048;
constexpr int KS_ROWS = 2176, QS_ROWS = 256;
constexpr float LOG2E = 1.4426950408889634f;
constexpr float NORM_EPS = 1e-6f, GN_EPS = 64e-5f;
constexpr float LAM_INIT = 0.35550906759096934f;
constexpr size_t O_Y = 0, O_WKVP = 17825792, O_SHP = 17956864, O_KP = 17958912, O_VP = 34736128, O_WKVS = 51513344, O_SHS = 52561920, O_KS = 52578304, O_VS = 53626880, O_TOTAL = 54675456;
constexpr size_t MiB = 1u << 20;
constexpr size_t WS_MOD = 1 * MiB;
constexpr size_t MOD_KV_OFF = 2ull * 18 * 9216;
constexpr size_t WS_W = 4 * MiB;
constexpr size_t WE_IN = 0;
constexpr size_t WE_OUT = WE_IN + 4ull * 5632 * 1024;
constexpr size_t WE_RKV = WE_OUT + 4ull * 1024 * 2816;
constexpr size_t WE_L2 = WE_RKV + 3328ull * 2048;
constexpr size_t WE_WO = WE_L2 + 3072ull * 256;
constexpr size_t WE_KV = WE_WO + 1024ull * 1024;
constexpr size_t WE_Q = WE_KV + 2048ull * 1024;
constexpr size_t WE_DO = WE_Q + 1024ull * 1024;
constexpr size_t WE_END = WE_DO + 1024ull * 1024;
static_assert(WS_W + WE_END * 2 <= 96 * MiB, "weights region");
constexpr size_t WS_RAW = 96 * MiB;
constexpr size_t WS_A = 164 * MiB;
constexpr size_t WS_A2 = 232 * MiB;
constexpr size_t WS_T = 266 * MiB;
constexpr size_t WS_H = WS_T;
constexpr size_t WS_R = WS_T, WS_K = WS_T + 34 * MiB, WS_V = WS_T + 68 * MiB, WS_G = WS_T + 102 * MiB, WS_LORA = WS_T + 136 * MiB;
constexpr size_t WS_QP = WS_T, WS_QS = WS_T + 32 * MiB, WS_KP = WS_T + 40 * MiB, WS_VP = WS_T + 72 * MiB, WS_KSB = WS_T + 104 * MiB, WS_VSB = WS_T + 172 * MiB;
constexpr size_t WS_END = WS_T + 240 * MiB;
constexpr size_t WS_PART = WS_T + 96 * MiB;
constexpr int NPART = 11;
constexpr size_t WS_OP0 = WS_RAW, WS_OP1 = WS_A2, WS_OS = WS_A + 40 * MiB;
constexpr size_t WS_X16 = WS_RAW + 34 * MiB;
constexpr size_t WS_Y = WS_T + 138 * MiB;
static_assert(WS_H + (size_t)NTOK * DFF * 2 <= WS_END && WS_LORA + (size_t)NTOK * 256 * 2 <= WS_END, "overlay");

constexpr int LDS_BYTES = 147456;

__device__ __forceinline__ unsigned f2bf(float f) { unsigned u = __builtin_bit_cast(unsigned, f); return (u + 0x7fffu + ((u >> 16) & 1u)) >> 16; }
__device__ __forceinline__ unsigned pk2(float lo, float hi) { return f2bf(lo) | (f2bf(hi) << 16); }
__device__ __forceinline__ float bflo(unsigned w) { return __builtin_bit_cast(float, w << 16); }
__device__ __forceinline__ float bfhi(unsigned w) { return __builtin_bit_cast(float, w & 0xffff0000u); }
__device__ __forceinline__ float wave_sum(float v) {
#pragma unroll
    for (int o = 1; o < 64; o <<= 1) v += __shfl_xor(v, o);
    return v;
}
__device__ __forceinline__ float fsigmoid(float x) { return __builtin_amdgcn_rcpf(1.f + __builtin_amdgcn_exp2f(-x * LOG2E)); }
#define LDS_WAIT() asm volatile("s_waitcnt lgkmcnt(0)" ::: "memory")

struct Args { const float* in[37]; float* out; unsigned char* ws; int ph_lo, ph_hi; };

enum { EM_H = 0, EM_RAW, EM_R1, EM_R2, EM_KV, EM_Q, EM_ATOM };
constexpr double INVREV0 = 0.15915494309189535, INVREV1 = 0.03086376340470123, INVREV2 = 0.005985185712713705, INVREV3 = 0.001160663641240061,
                 INVREV4 = 0.00022507907903927653, INVREV5 = 4.364795279280289e-05, INVREV6 = 8.464330808241401e-06, INVREV7 = 1.6414262627950345e-06;
__device__ __forceinline__ void rope_cs(int pos, double ir, float& c, float& s) {
    double rv = (double)pos * ir; rv -= __builtin_floor(rv); const float f = (float)rv;
    c = __builtin_amdgcn_cosf(f); s = __builtin_amdgcn_sinf(f);
}
__device__ __forceinline__ void rope8(f32x4& v0, f32x4& v1, int pos, int fq) {
    f32x4 p0, p1;
#pragma unroll
    for (int i = 0; i < 4; ++i) { p0[i] = __shfl_xor(v0[i], 16); p1[i] = __shfl_xor(v1[i], 16); }
    if (fq < 2) {
        const float sg = (fq == 0) ? -1.f : 1.f; float c, s;
        rope_cs(pos, INVREV0, c, s); v0[0] = v0[0] * c + sg * p0[0] * s;
        rope_cs(pos, INVREV1, c, s); v0[1] = v0[1] * c + sg * p0[1] * s;
        rope_cs(pos, INVREV2, c, s); v0[2] = v0[2] * c + sg * p0[2] * s;
        rope_cs(pos, INVREV3, c, s); v0[3] = v0[3] * c + sg * p0[3] * s;
        rope_cs(pos, INVREV4, c, s); v1[0] = v1[0] * c + sg * p1[0] * s;
        rope_cs(pos, INVREV5, c, s); v1[1] = v1[1] * c + sg * p1[1] * s;
        rope_cs(pos, INVREV6, c, s); v1[2] = v1[2] * c + sg * p1[2] * s;
        rope_cs(pos, INVREV7, c, s); v1[3] = v1[3] * c + sg * p1[3] * s;
    }
}
__device__ __forceinline__ void st_bf16x8(bf16* p, const f32x4& v0, const f32x4& v1) {
    v4u w; w.x = pg8::cvt_pk_bf16(v0[0], v0[1]); w.y = pg8::cvt_pk_bf16(v0[2], v0[3]); w.z = pg8::cvt_pk_bf16(v1[0], v1[1]); w.w = pg8::cvt_pk_bf16(v1[2], v1[3]);
    *(v4u*)p = w;
}
template <int mode> struct EpiG {
    static constexpr bool PERM = true, AFTER_DRAIN = false;
    unsigned char* ws; float* f0;
    const float *c0, *c1;
    __device__ __forceinline__ void operator()(const pg8::f32x4 (&acc)[2][2][4][2], const pg8::Unit& u, int wr, int wc, int fr, int fq) const {
        const int rowb = u.pm * 256 + wr * 64 + fr;
        if constexpr (mode == EM_H) {
            const int col = u.pn * 128 + wc * 32 + 8 * fq;
#pragma unroll
            for (int ai = 0; ai < 2; ++ai)
#pragma unroll
                for (int m = 0; m < 4; ++m) {
                    const int row = rowb + ai * 128 + m * 16;
                    f32x4 h0, h1;
#pragma unroll
                    for (int i = 0; i < 4; ++i) { const float g0 = acc[ai][0][m][0][i], g1 = acc[ai][0][m][1][i];
                        h0[i] = g0 * fsigmoid(g0) * acc[ai][1][m][0][i]; h1[i] = g1 * fsigmoid(g1) * acc[ai][1][m][1][i]; }
                    st_bf16x8((bf16*)(ws + WS_H) + (size_t)row * DFF + col, h0, h1);
                }
        } else if constexpr (mode == EM_RAW) {
#pragma unroll
            for (int ai = 0; ai < 2; ++ai)
#pragma unroll
                for (int m = 0; m < 4; ++m) {
                    const int row = rowb + ai * 128 + m * 16;
#pragma unroll
                    for (int bj = 0; bj < 2; ++bj) st_bf16x8((bf16*)f0 + (size_t)row * D + u.pn * 256 + bj * 128 + wc * 32 + 8 * fq, acc[ai][bj][m][0], acc[ai][bj][m][1]);
                }
        } else if constexpr (mode == EM_ATOM) {
            bf16* base = (bf16*)f0 + (size_t)(u.kofs >> 8) * NS * D;
#pragma unroll
            for (int ai = 0; ai < 2; ++ai)
#pragma unroll
                for (int m = 0; m < 4; ++m) {
                    const int row = rowb + ai * 128 + m * 16;
#pragma unroll
                    for (int bj = 0; bj < 2; ++bj) st_bf16x8(base + (size_t)row * D + u.pn * 256 + bj * 128 + wc * 32 + 8 * fq, acc[ai][bj][m][0], acc[ai][bj][m][1]);
                }
        } else if constexpr (mode == EM_R1) {
            if (u.pn < 12) {
                const int t = u.pn >> 2; bf16* dst = (bf16*)(ws + WS_R + (size_t)t * (WS_K - WS_R));
#pragma unroll
                for (int ai = 0; ai < 2; ++ai)
#pragma unroll
                    for (int m = 0; m < 4; ++m) {
                        const int row = rowb + ai * 128 + m * 16;
#pragma unroll
                        for (int bj = 0; bj < 2; ++bj) st_bf16x8(dst + (size_t)row * D + (u.pn & 3) * 256 + bj * 128 + wc * 32 + 8 * fq, acc[ai][bj][m][0], acc[ai][bj][m][1]);
                    }
            } else {
#pragma unroll
                for (int ai = 0; ai < 2; ++ai)
#pragma unroll
                    for (int m = 0; m < 4; ++m) {
                        const int row = rowb + ai * 128 + m * 16;
#pragma unroll
                        for (int bj = 0; bj < 2; ++bj) {
                            f32x4 v0 = acc[ai][bj][m][0], v1 = acc[ai][bj][m][1];
                            if (bj == 1) {
#pragma unroll
                                for (int i = 0; i < 4; ++i) { v0[i] = fsigmoid(v0[i]); v1[i] = fsigmoid(v1[i]); }
                            } else if (wc < 2) {
#pragma unroll
                                for (int i = 0; i < 4; ++i) { v0[i] = 1.f - 2.f * __builtin_amdgcn_rcpf(__builtin_amdgcn_exp2f(2.f * LOG2E * v0[i]) + 1.f);
                                                              v1[i] = 1.f - 2.f * __builtin_amdgcn_rcpf(__builtin_amdgcn_exp2f(2.f * LOG2E * v1[i]) + 1.f); }
                            }
                            st_bf16x8((bf16*)(ws + WS_LORA) + (size_t)row * 256 + bj * 128 + wc * 32 + 8 * fq, v0, v1);
                        }
                    }
            }
        } else if constexpr (mode == EM_R2) {
            const int t = u.pn >> 2;
#pragma unroll
            for (int ai = 0; ai < 2; ++ai)
#pragma unroll
                for (int m = 0; m < 4; ++m) {
                    const int row = rowb + ai * 128 + m * 16;
#pragma unroll
                    for (int bj = 0; bj < 2; ++bj) {
                        const int col = (u.pn & 3) * 256 + bj * 128 + wc * 32 + 8 * fq;
                        f32x4 v0 = acc[ai][bj][m][0], v1 = acc[ai][bj][m][1];
                        if (t == 0) {
                            const f32x4 z0 = *(const f32x4*)(c0 + col), z1 = *(const f32x4*)(c0 + col + 4);
#pragma unroll
                            for (int i = 0; i < 4; ++i) { v0[i] = 0.6065306597126334f * LOG2E * fsigmoid(v0[i] + z0[i]);
                                                          v1[i] = 0.6065306597126334f * LOG2E * fsigmoid(v1[i] + z1[i]); }
                            st_bf16x8((bf16*)f0 + (size_t)row * D + col, v0, v1);
                        } else if (t == 1) {
                            const f32x4 z0 = *(const f32x4*)(c1 + col), z1 = *(const f32x4*)(c1 + col + 4);
#pragma unroll
                            for (int i = 0; i < 4; ++i) { v0[i] = fsigmoid(v0[i] + z0[i]); v1[i] = fsigmoid(v1[i] + z1[i]); }
                            st_bf16x8((bf16*)(ws + WS_A2) + (size_t)row * D + col, v0, v1);
                        } else st_bf16x8((bf16*)(ws + WS_G) + (size_t)row * D + col, v0, v1);
                    }
                }
        } else if constexpr (mode == EM_KV) {
            const bool isk = u.pn < 4; const bool dorope = isk && ((wc & 1) == 0);
#pragma unroll
            for (int ai = 0; ai < 2; ++ai)
#pragma unroll
                for (int m = 0; m < 4; ++m) {
                    const int row = rowb + ai * 128 + m * 16;
                    const bool smp = row >= NP; const int rs = row - NP;
                    const int pos = smp ? PAST + (rs & 63) : (row & 8191);
                    const size_t orow = smp ? (isk ? O_KS : O_VS) + (size_t)rs * D : (isk ? O_KP : O_VP) + (size_t)row * D;
                    const size_t boff = smp ? (isk ? WS_KSB : WS_VSB) + ((size_t)(rs >> 6) * KS_ROWS + PAST + (rs & 63)) * D * 2 : (isk ? WS_KP : WS_VP) + (size_t)row * D * 2;
                    bf16* brow = (bf16*)(ws + boff);
#pragma unroll
                    for (int bj = 0; bj < 2; ++bj) {
                        const int col = (u.pn & 3) * 256 + bj * 128 + wc * 32 + 8 * fq;
                        f32x4 v0 = acc[ai][bj][m][0], v1 = acc[ai][bj][m][1];
                        if (dorope) rope8(v0, v1, pos, fq);
                        float* p = f0 + orow + col; *(f32x4*)p = v0; *(f32x4*)(p + 4) = v1;
                        st_bf16x8(brow + col, v0, v1);
                    }
                }
        } else {
            const bool dorope = ((wc & 1) == 0);
#pragma unroll
            for (int ai = 0; ai < 2; ++ai)
#pragma unroll
                for (int m = 0; m < 4; ++m) {
                    const int row = rowb + ai * 128 + m * 16;
                    const bool smp = row >= NP; const int rs = row - NP;
                    const int pos = smp ? PAST + (rs & 63) : (row & 8191);
                    const size_t boff = smp ? WS_QS + ((size_t)(rs >> 6) * QS_ROWS + 128 + (rs & 63)) * D * 2 : WS_QP + (size_t)row * D * 2;
                    bf16* brow = (bf16*)(ws + boff);
#pragma unroll
                    for (int bj = 0; bj < 2; ++bj) {
                        const int col = u.pn * 256 + bj * 128 + wc * 32 + 8 * fq;
                        f32x4 v0 = acc[ai][bj][m][0], v1 = acc[ai][bj][m][1];
                        if (dorope) rope8(v0, v1, pos, fq);
                        v0 = v0 * attn_body::C2; v1 = v1 * attn_body::C2;
                        st_bf16x8(brow + col, v0, v1);
                    }
                }
        }
    }
};

__device__ __forceinline__ void tr_item(const float* W, int ldw, int k0, int n0, bf16* WT, int ldt, int drow0, int kdst0, const float* mu, int mumode, LAS float* scr, int lane) {
#pragma unroll
    for (int i = 0; i < 32; ++i) { const int kk = 2 * i + (lane >> 5); float v = W[(size_t)(k0 + kk) * ldw + n0 + (lane & 31)];
        if (mumode) { const float mv = mu[k0 + kk]; v *= (mumode == 1) ? mv : 1.f - mv; }
        scr[kk * 33 + (lane & 31)] = v; }
    LDS_WAIT(); asm volatile("" ::: "memory");
    const int c = lane & 7;
#pragma unroll
    for (int j = 0; j < 4; ++j) { const int n = (lane >> 3) + 8 * j; const LAS float* s = scr + (8 * c) * 33 + n;
        v4u o; o.x = pk2(s[0 * 33], s[1 * 33]); o.y = pk2(s[2 * 33], s[3 * 33]); o.z = pk2(s[4 * 33], s[5 * 33]); o.w = pk2(s[6 * 33], s[7 * 33]);
        *(v4u*)(WT + (size_t)(drow0 + n) * ldt + kdst0 + 8 * c) = o; }
    LDS_WAIT(); asm volatile("" ::: "memory");
}
__device__ __forceinline__ void zero_item(bf16* WT, int ldt, int drow0, int kdst0, int lane) {
    const int c = lane & 7;
#pragma unroll
    for (int j = 0; j < 4; ++j) { const int n = (lane >> 3) + 8 * j; *(v4u*)(WT + (size_t)(drow0 + n) * ldt + kdst0 + 8 * c) = (v4u){0u, 0u, 0u, 0u}; }
}
__device__ __forceinline__ void tr_job(const float* W, int N, bf16* WT, int ldt, int drow0, int kdst0, const float* mu, int mumode, int item, LAS float* scr, int lane) {
    const int nblk = N / 32, kb = item / nblk, nb = item % nblk;
    tr_item(W, N, 64 * kb, 32 * nb, WT, ldt, drow0 + 32 * nb, kdst0 + 64 * kb, mu, mumode, scr, lane);
}
__device__ __forceinline__ void p0_phase(const Args& a, LAS unsigned char* lds, int tid, int wave, int lane, int vcu, int G) {
    unsigned char* ws = a.ws;
    bf16* WB = (bf16*)(ws + WS_W);
    LAS float* scr = (LAS float*)(lds + wave * 16384);
    const int gw = vcu * NWAVES + wave, NGW = G * NWAVES;
    constexpr int I_IN = 16 * 176, I_OUT = 44 * 32, I_SQ = 16 * 32, I_L64 = 16 * 2, I_L128 = 16 * 4, I_L2 = 384, I_KV = 16 * 64;
    constexpr int C0 = 4 * I_IN, C1 = C0 + 4 * I_OUT, C2 = C1 + 6 * I_SQ, C3 = C2 + 4 * I_L64, C4 = C3 + 2 * I_L128, C5 = C4 + I_L2, C6 = C5 + I_SQ, C7 = C6 + I_KV, C8 = C7 + I_SQ, C9 = C8 + I_SQ;
    const float* mu = a.in[13];
    for (int it = gw; it < C9; it += NGW) {
        if (it < C0) { const int f = it / I_IN, r = it % I_IN; const int kb = r / 176, nb = r % 176;
            const int n0 = 32 * nb, half = n0 / DFF, j = n0 % DFF; const int drow = (j / 128) * 256 + half * 128 + (j % 128);
            tr_item(a.in[11] + (size_t)f * 1024 * 5632, 5632, 64 * kb, n0, WB + WE_IN + (size_t)f * 5632 * 1024, 1024, drow, 64 * kb, nullptr, 0, scr, lane);
        } else if (it < C1) { const int r0 = it - C0, f = r0 / I_OUT, r = r0 % I_OUT;
            tr_job(a.in[12] + (size_t)f * DFF * 1024, 1024, WB + WE_OUT + (size_t)f * 1024 * DFF, DFF, 0, 0, nullptr, 0, r, scr, lane);
        } else if (it < C2) { const int r0 = it - C1, jp = r0 / I_SQ, r = r0 % I_SQ; const int j = jp >> 1, part = jp & 1;
            const int mi = (j == 0) ? 0 : (j == 1) ? 2 : 3;
            tr_job(a.in[14] + (size_t)j * 1024 * 1024, 1024, WB + WE_RKV, 2048, j * 1024, part ? 1024 : 0, mu + mi * 1024, part ? 2 : 1, r, scr, lane);
        } else if (it < C3) { const int r0 = it - C2, jp = r0 / I_L64, r = r0 % I_L64; const int j = jp >> 1, part = jp & 1;
            tr_job(j == 0 ? a.in[16] : a.in[19], 64, WB + WE_RKV, 2048, 3072 + 64 * j, part ? 1024 : 0, mu + (j == 0 ? 1 : 4) * 1024, part ? 2 : 1, r, scr, lane);
        } else if (it < C4) { const int r0 = it - C3, part = r0 / I_L128, r = r0 % I_L128;
            tr_job(a.in[21], 128, WB + WE_RKV, 2048, 3200, part ? 1024 : 0, mu + 5 * 1024, part ? 2 : 1, r, scr, lane);
        } else if (it < C5) { const int r0 = it - C4, rb = r0 / 128, rem = r0 % 128, kc = rem / 32, nb = rem % 32;
            bf16* WT = WB + WE_L2; const int drow = rb * 1024 + 32 * nb;
            if (rb == 0 && kc == 0) tr_item(a.in[17], 1024, 0, 32 * nb, WT, 256, drow, 0, nullptr, 0, scr, lane);
            else if (rb == 1 && kc == 1) tr_item(a.in[20], 1024, 0, 32 * nb, WT, 256, drow, 64, nullptr, 0, scr, lane);
            else if (rb == 2 && kc >= 2) tr_item(a.in[22], 1024, (kc - 2) * 64, 32 * nb, WT, 256, drow, kc * 64, nullptr, 0, scr, lane);
            else zero_item(WT, 256, drow, kc * 64, lane);
        } else if (it < C6) { tr_job(a.in[28], 1024, WB + WE_WO, 1024, 0, 0, nullptr, 0, it - C5, scr, lane);
        } else if (it < C7) { tr_job(a.in[32], 2048, WB + WE_KV, 1024, 0, 0, nullptr, 0, it - C6, scr, lane);
        } else if (it < C8) { tr_job(a.in[33], 1024, WB + WE_Q, 1024, 0, 0, nullptr, 0, it - C7, scr, lane);
        } else { tr_job(a.in[36], 1024, WB + WE_DO, 1024, 0, 0, nullptr, 0, it - C8, scr, lane); }
    }
    __syncthreads();
    LAS float* sc = (LAS float*)lds;
    LAS float* red = (LAS float*)(lds + 73728);
    for (int i = tid; i < NSEQ * 1024; i += 512) { const int s = i >> 10, k = i & 1023; const float c = (s < 2) ? a.in[2][s * 1024 + k] : a.in[3][(s - 2) * 1024 + k]; sc[i] = c * fsigmoid(c); }
    __syncthreads();
    float* MOD = (float*)(ws + WS_MOD);
    for (int item = vcu; item < 320; item += G) {
        const float* W; const float* bias; float* dst; int N, col0, dstride;
        if (item < 288) { const int l = item / 144, cg_ = item % 144; N = 9216; col0 = cg_ * 64; W = a.in[8] + (size_t)l * 1024 * 9216; bias = a.in[9] + l * 9216; dst = MOD + (size_t)l * 18 * 9216; dstride = 9216; }
        else { N = 2048; col0 = (item - 288) * 64; W = a.in[29]; bias = a.in[30]; dst = MOD + MOD_KV_OFF; dstride = 2048; }
        float acc[NSEQ];
#pragma unroll
        for (int s = 0; s < NSEQ; ++s) acc[s] = 0.f;
        const float* wp = W + (size_t)(wave * 128) * N + col0 + lane;
        for (int k = 0; k < 128; k += 4) {
            const float w0 = wp[(size_t)(k + 0) * N], w1 = wp[(size_t)(k + 1) * N], w2 = wp[(size_t)(k + 2) * N], w3 = wp[(size_t)(k + 3) * N];
#pragma unroll
            for (int s = 0; s < NSEQ; ++s) { const f32x4 c4 = *(const LAS f32x4*)(sc + s * 1024 + wave * 128 + k); acc[s] += c4[0] * w0 + c4[1] * w1 + c4[2] * w2 + c4[3] * w3; }
        }
#pragma unroll
        for (int s = 0; s < NSEQ; ++s) red[(wave * NSEQ + s) * 64 + lane] = acc[s];
        __syncthreads();
        for (int o = tid; o < NSEQ * 64; o += 512) { const int s = o >> 6, l = o & 63; float v = bias[col0 + l];
#pragma unroll
            for (int w = 0; w < 8; ++w) v += red[(w * NSEQ + s) * 64 + l];
            dst[(size_t)s * dstride + col0 + l] = v; }
        __syncthreads();
    }
}

__device__ __forceinline__ void ld_row(f32x4 (&v)[4], const float* p, int lane) {
#pragma unroll
    for (int j = 0; j < 4; ++j) v[j] = *(const f32x4*)(p + 4 * lane + 256 * j);
}
__device__ __forceinline__ void ld_row_nt(f32x4 (&v)[4], const float* p, int lane) {
#pragma unroll
    for (int j = 0; j < 4; ++j) v[j] = __builtin_nontemporal_load((const f32x4*)(p + 4 * lane + 256 * j));
}
__device__ __forceinline__ float sumsq(const f32x4 (&v)[4]) { float s = 0.f;
#pragma unroll
    for (int j = 0; j < 4; ++j) s += (v[j][0] * v[j][0] + v[j][1] * v[j][1]) + (v[j][2] * v[j][2] + v[j][3] * v[j][3]);
    return wave_sum(s); }
template <int mode> __device__ __forceinline__ void rowpass(const Args& a, int gw, int NGW, int lane) {
    if (!EN_RP) return;
    unsigned char* ws = a.ws; float* XO = a.out + O_Y; bf16* X = (bf16*)(ws + WS_X16); const float* RAW = (const float*)(ws + WS_RAW);
    const float* MOD = (const float*)(ws + WS_MOD); const float* KVMOD = MOD + MOD_KV_OFF; const float* NG = a.in[10];
    bf16* A = (bf16*)(ws + WS_A); bf16* A2 = (bf16*)(ws + WS_A2);
    int lpost = 0, gchunk = 0, ngpost = 0; float gs = 0.f; bool has_raw = mode != 0;
    int lpre = 0, ngpre = 0, schunk = 0; bool has_a = mode != 6;
    switch (mode) {
        case 0: lpre = 0; ngpre = 0; schunk = 0; break;
        case 1: lpost = 0; gchunk = 2; ngpost = 1; gs = 0.5f; lpre = 0; ngpre = 2; schunk = 3; break;
        case 2: lpost = 0; gchunk = 5; ngpost = 3; gs = 1.0f; lpre = 0; ngpre = 4; schunk = 6; break;
        case 3: lpost = 0; gchunk = 8; ngpost = 5; gs = 0.5f; lpre = 1; ngpre = 0; schunk = 0; break;
        case 4: lpost = 1; gchunk = 2; ngpost = 1; gs = 0.5f; lpre = 1; ngpre = 2; schunk = 3; break;
        case 5: lpost = 1; gchunk = 5; ngpost = 3; gs = 1.0f; lpre = 1; ngpre = 4; schunk = 6; break;
        default: lpost = 1; gchunk = 8; ngpost = 5; gs = 0.5f; break;
    }
    const float* gate = MOD + (size_t)lpost * 18 * 9216 + gchunk * 1024;
    const float* ngp = NG + (lpost * 6 + ngpost) * 1024;
    const float* ng1 = NG + (lpre * 6 + ngpre) * 1024;
    const float* sh1 = MOD + (size_t)lpre * 18 * 9216 + schunk * 1024; const float* sc1 = sh1 + 1024;
#define RP_LOAD(row, x, r) do { const bool smp_ = (row) >= NP; const int rs_ = (row) - NP; \
        if (mode == 0 || mode == 1) ld_row_nt(x, smp_ ? a.in[1] + (size_t)rs_ * D : a.in[0] + (size_t)(row) * D, lane); else { _Pragma("unroll") for (int j = 0; j < 4; ++j) { const v2u w_ = __builtin_nontemporal_load((const v2u*)(X + (size_t)(row) * D + 4 * lane + 256 * j)); x[j] = (f32x4){bflo(w_.x), bfhi(w_.x), bflo(w_.y), bfhi(w_.y)}; } } \
        if (has_raw) { if (smp_) { constexpr int np_ = (mode == 2 || mode == 5) ? 4 : NPART; const bf16* pp_ = (const bf16*)(ws + WS_PART) + (size_t)rs_ * D + 4 * lane; _Pragma("unroll") for (int j = 0; j < 4; ++j) r[j] = (f32x4){0.f, 0.f, 0.f, 0.f}; \
                for (int p_ = 0; p_ < np_; ++p_) { _Pragma("unroll") for (int j = 0; j < 4; ++j) { const v2u w_ = *(const v2u*)(pp_ + (size_t)p_ * NS * D + 256 * j); r[j] = r[j] + (f32x4){bflo(w_.x), bfhi(w_.x), bflo(w_.y), bfhi(w_.y)}; } } } \
            else { _Pragma("unroll") for (int j = 0; j < 4; ++j) { const v2u w_ = __builtin_nontemporal_load((const v2u*)((const bf16*)RAW + (size_t)(row) * D + 4 * lane + 256 * j)); r[j] = (f32x4){bflo(w_.x), bfhi(w_.x), bflo(w_.y), bfhi(w_.y)}; } } } } while (0)
    for (int row0 = gw; row0 < NTOK; row0 += 2 * NGW) {
        const int row1 = row0 + NGW; const bool has1 = row1 < NTOK;
        f32x4 xx[2][4], rr[2][4];
        RP_LOAD(row0, xx[0], rr[0]);
        if (has1) RP_LOAD(row1, xx[1], rr[1]);
#pragma unroll
      for (int e = 0; e < 2; ++e) {
        if (e == 1 && !has1) break;
        const int row = e ? row1 : row0;
        f32x4 (&x)[4] = xx[e]; f32x4 (&r)[4] = rr[e];
        const bool smp = row >= NP; const int rs = row - NP;
        const int s = smp ? 2 + (rs >> 6) : (row >> 13);
        if (has_raw) {
            f32x4 g[4], n[4]; ld_row(g, gate + (size_t)s * 9216, lane); ld_row(n, ngp, lane);
            const float rstd = 1.f / sqrtf(sumsq(r) * (1.f / D) + NORM_EPS) * gs;
#pragma unroll
            for (int j = 0; j < 4; ++j) x[j] = x[j] + g[j] * r[j] * n[j] * rstd;
#pragma unroll
            for (int j = 0; j < 4; ++j) { if (mode == 6) __builtin_nontemporal_store(x[j], (f32x4*)(XO + (size_t)row * D + 4 * lane + 256 * j));
                else __builtin_nontemporal_store((v2u){pk2(x[j][0], x[j][1]), pk2(x[j][2], x[j][3])}, (v2u*)(X + (size_t)row * D + 4 * lane + 256 * j)); }
        }
        if (has_a) {
            const float rstd = 1.f / sqrtf(sumsq(x) * (1.f / D) + NORM_EPS);
            f32x4 n[4], sh[4], sc[4]; ld_row(n, ng1, lane); ld_row(sh, sh1 + (size_t)s * 9216, lane); ld_row(sc, sc1 + (size_t)s * 9216, lane);
            f32x4 y[4];
#pragma unroll
            for (int j = 0; j < 4; ++j) y[j] = x[j] * n[j] * rstd * (sc[j] + 1.f) + sh[j];
            if (mode != 1) {
#pragma unroll
                for (int j = 0; j < 4; ++j) *(v2u*)(A + (size_t)row * D + 4 * lane + 256 * j) = (v2u){pk2(y[j][0], y[j][1]), pk2(y[j][2], y[j][3])};
            } else {
                const int t = smp ? (rs & 63) : (row & 8191); const int len = smp ? 64 : 8192;
#pragma unroll
                for (int j = 0; j < 4; ++j) { const v2u w = (v2u){pk2(y[j][0], y[j][1]), pk2(y[j][2], y[j][3])};
                    *(v2u*)(A + (size_t)row * 2048 + 1024 + 4 * lane + 256 * j) = w;
                    if (t + 1 < len) *(v2u*)(A + (size_t)(row + 1) * 2048 + 4 * lane + 256 * j) = w; }
                if (t == 0) {
#pragma unroll
                    for (int j = 0; j < 4; ++j) { v2u w = (v2u){0u, 0u};
                        if (smp) { const f32x4 sv = *(const f32x4*)(a.in[5] + (size_t)(rs >> 6) * D + 4 * lane + 256 * j); w = (v2u){pk2(sv[0], sv[1]), pk2(sv[2], sv[3])}; }
                        *(v2u*)(A + (size_t)row * 2048 + 4 * lane + 256 * j) = w; }
                }
                if (t == len - 1) { float* so = a.out + (smp ? O_SHS + (size_t)(rs >> 6) * D : O_SHP + (size_t)(row >> 13) * D);
#pragma unroll
                    for (int j = 0; j < 4; ++j) *(f32x4*)(so + 4 * lane + 256 * j) = y[j]; }
            }
        }
        if (mode == 3) {
            const float rstd = 1.f / sqrtf(sumsq(x) * (1.f / D) + NORM_EPS);
            f32x4 n[4], sh[4], sc[4]; ld_row(n, a.in[31], lane); ld_row(sh, KVMOD + (size_t)s * 2048, lane); ld_row(sc, KVMOD + (size_t)s * 2048 + 1024, lane);
#pragma unroll
            for (int j = 0; j < 4; ++j) { const f32x4 y = x[j] * n[j] * rstd * (sc[j] + 1.f) + sh[j];
                *(v2u*)(A2 + (size_t)row * D + 4 * lane + 256 * j) = (v2u){pk2(y[0], y[1]), pk2(y[2], y[3])}; }
        }
      }
    }
#undef RP_LOAD
}

template <int N> __device__ __forceinline__ float ror16(float x) { return __builtin_bit_cast(float, __builtin_amdgcn_update_dpp(0, __builtin_bit_cast(int, x), 0x120 + N, 0xF, 0xF, false)); }
__device__ __forceinline__ float red16(float x) { x += ror16<8>(x); x += ror16<4>(x); x += ror16<2>(x); x += ror16<1>(x); return x; }
constexpr int SC_STEPS = 32, SC_STEPB = 1536, SC_CCOFF = SC_STEPS * SC_STEPB, SC_BUFB = SC_CCOFF + 128, SC_YOFF = 2 * SC_BUFB;
static_assert(SC_YOFF + 2 * 16384 <= 131072 + 320, "scan LDS map");
struct PrepRegs { v2u k[2], a[2], r[2], v[2], w[2]; };
__device__ __forceinline__ void prep_load(PrepRegs& P, const bf16* Rb, const bf16* Kb, const bf16* Vb, const bf16* Ab, const bf16* Wb, size_t off0) {
#pragma unroll
    for (int p = 0; p < 2; ++p) { const size_t off = off0 + (size_t)p * D;
        P.k[p] = *(const v2u*)(Kb + off); P.a[p] = *(const v2u*)(Ab + off); P.r[p] = *(const v2u*)(Rb + off); P.v[p] = *(const v2u*)(Vb + off); P.w[p] = *(const v2u*)(Wb + off); }
}
__device__ __forceinline__ void prep_compute(const PrepRegs& P, LAS unsigned char* buf, int st, int cg4, const f32x4& kkc, const f32x4& kac) {
    f32x4 kk[2], bb[2], kp[2], w0 = (f32x4){0.f, 0.f, 0.f, 0.f};
#pragma unroll
    for (int p = 0; p < 2; ++p) {
        const f32x4 k = (f32x4){bflo(P.k[p].x), bfhi(P.k[p].x), bflo(P.k[p].y), bfhi(P.k[p].y)};
        const f32x4 av = (f32x4){bflo(P.a[p].x), bfhi(P.a[p].x), bflo(P.a[p].y), bfhi(P.a[p].y)};
        const f32x4 r = (f32x4){bflo(P.r[p].x), bfhi(P.r[p].x), bflo(P.r[p].y), bfhi(P.r[p].y)};
        const f32x4 v = (f32x4){bflo(P.v[p].x), bfhi(P.v[p].x), bflo(P.v[p].y), bfhi(P.v[p].y)};
        if (p == 0) w0 = (f32x4){__builtin_amdgcn_exp2f(-bflo(P.w[0].x)), __builtin_amdgcn_exp2f(-bfhi(P.w[0].x)), __builtin_amdgcn_exp2f(-bflo(P.w[0].y)), __builtin_amdgcn_exp2f(-bfhi(P.w[0].y))};
        const f32x4 wd = (p == 0) ? w0 : (f32x4){__builtin_amdgcn_exp2f(-bflo(P.w[1].x)), __builtin_amdgcn_exp2f(-bfhi(P.w[1].x)), __builtin_amdgcn_exp2f(-bflo(P.w[1].y)), __builtin_amdgcn_exp2f(-bfhi(P.w[1].y))};
        const f32x4 uu = k * kkc;
        const float n2 = red16((uu[0] * uu[0] + uu[1] * uu[1]) + (uu[2] * uu[2] + uu[3] * uu[3]));
        const float inv = 1.f / fmaxf(sqrtf(n2), 1e-12f);
        kk[p] = uu * inv; bb[p] = kk[p] * av; kp[p] = k * ((av - 1.f) * kac + 1.f);
        LAS unsigned char* b = buf + (2 * st + p) * SC_STEPB + cg4 * 16;
        *(LAS f32x4*)(b) = wd; *(LAS f32x4*)(b + 256) = kp[p]; *(LAS f32x4*)(b + 768) = bb[p]; *(LAS f32x4*)(b + 1024) = r; *(LAS f32x4*)(b + 1280) = v;
        if (p == 0) *(LAS f32x4*)(b + 512) = kk[0];
        else *(LAS f32x4*)(b + 512) = w0 * kk[1];
    }
    const f32x4 t1 = bb[0] * kk[1], t2 = kp[0] * kk[1];
    const float c1 = red16((t1[0] + t1[1]) + (t1[2] + t1[3])), c2 = red16((t2[0] + t2[1]) + (t2[2] + t2[3]));
    if (cg4 == 0) { typedef float f32x2 __attribute__((ext_vector_type(2))); *(LAS f32x2*)(buf + SC_CCOFF + st * 8) = (f32x2){c1, c2}; }
}
__device__ __forceinline__ void scan_item(const Args& a, LAS unsigned char* lds, int wave, int lane, int tok0, int nsteps, int h, int rg, const float* s0, float* sT, bool reuse) {
    unsigned char* ws = a.ws;
    const bf16* Rb = (const bf16*)(ws + WS_R); const bf16* Kb = (const bf16*)(ws + WS_K); const bf16* Vb = (const bf16*)(ws + WS_V); const bf16* Ab = (const bf16*)(ws + WS_A2);
    const bf16* Wb = (const bf16*)(ws + WS_A); bf16* Y = (bf16*)(ws + WS_Y);
    const int nch = nsteps / SC_STEPS;
    const bool is_scan = wave < 2, is_red = (wave == 4 || wave == 5), is_prep = ((wave & 2) != 0) && !reuse;
    const int plane = ((wave & 1) | ((wave >> 2) << 1)) * 64 + lane, st = plane >> 4, cg4 = plane & 15;
    const size_t poff = (size_t)(tok0 + 2 * st) * D + h * 64 + cg4 * 4;
    f32x4 kkc = (f32x4){0.f, 0.f, 0.f, 0.f}, kac = kkc; PrepRegs P, P2;
    const int row4 = lane >> 4, kq = lane & 15, vrow = rg * 8 + (wave & 1) * 4 + row4;
    f32x4 S = (f32x4){0.f, 0.f, 0.f, 0.f};
    if (is_scan && s0) S = *(const f32x4*)(s0 + (size_t)vrow * 64 + kq * 4);
    if (is_prep) { kkc = *(const f32x4*)(a.in[23] + h * 64 + cg4 * 4); kac = *(const f32x4*)(a.in[24] + h * 64 + cg4 * 4);
        prep_load(P2, Rb, Kb, Vb, Ab, Wb, poff); prep_compute(P2, lds, st, cg4, kkc, kac);
        if (nch > 1) prep_load(P, Rb, Kb, Vb, Ab, Wb, poff + (size_t)SC_STEPS * D);
        if (nch > 2) prep_load(P2, Rb, Kb, Vb, Ab, Wb, poff + (size_t)2 * SC_STEPS * D); }
    __syncthreads();
    typedef float f32x2 __attribute__((ext_vector_type(2)));
    f32x2 Sa = (f32x2){S[0], S[1]}, Sb = (f32x2){S[2], S[3]};
    for (int c = 0; c < nch; ++c) {
        LAS unsigned char* buf = lds + (c & 1) * SC_BUFB;
        if (is_scan) {
            LAS float* yp = (LAS float*)(lds + SC_YOFF + (c & 1) * 16384) + (wave & 1) * 64 + lane;
            const LAS unsigned char* bp = buf + kq * 16; const LAS unsigned char* vp = buf + 1280 + vrow * 4;
            f32x4 Wv[3][2], KPv[3][2], KKv[3][2], BBv[3][2], Rv[3][2]; float Vv[3][2]; f32x2 CC[3];
#define SLOAD(slot, pr_) do { _Pragma("unroll") for (int e_ = 0; e_ < 2; ++e_) { const LAS unsigned char* q_ = bp + (2 * (pr_) + e_) * SC_STEPB; \
        Wv[slot][e_] = *(const LAS f32x4*)(q_); KPv[slot][e_] = *(const LAS f32x4*)(q_ + 256); KKv[slot][e_] = *(const LAS f32x4*)(q_ + 512); \
        BBv[slot][e_] = *(const LAS f32x4*)(q_ + 768); Rv[slot][e_] = *(const LAS f32x4*)(q_ + 1024); Vv[slot][e_] = *(const LAS float*)(vp + (2 * (pr_) + e_) * SC_STEPB); } \
        CC[slot] = *(const LAS f32x2*)(buf + SC_CCOFF + (pr_) * 8); } while (0)
#define LO2(x) ((f32x2){(x)[0], (x)[1]})
#define HI2(x) ((f32x2){(x)[2], (x)[3]})
            SLOAD(0, 0); SLOAD(1, 1);
#pragma unroll
            for (int pr = 0; pr < SC_STEPS / 2; ++pr) {
                if (pr + 2 < SC_STEPS / 2) SLOAD((pr + 2) % 3, pr + 2);
                const int q = pr % 3;
                const f32x2 e0 = Sa * LO2(KKv[q][0]) + Sb * HI2(KKv[q][0]);
                const f32x2 e1 = Sa * LO2(KKv[q][1]) + Sb * HI2(KKv[q][1]);
                const float v0 = Vv[q][0], v1 = Vv[q][1];
                const f32x2 Ta = Sa * LO2(Wv[q][0]) + LO2(KPv[q][0]) * v0, Tb = Sb * HI2(Wv[q][0]) + HI2(KPv[q][0]) * v0;
                const float sa0 = red16(e0[0] + e0[1]);
                const float d1 = red16(e1[0] + e1[1]) + v0 * CC[q][1];
                const float sa1 = d1 - sa0 * CC[q][0];
                Sa = Ta - LO2(BBv[q][0]) * sa0; Sb = Tb - HI2(BBv[q][0]) * sa0;
                const f32x2 y0 = Sa * LO2(Rv[q][0]) + Sb * HI2(Rv[q][0]);
                yp[(2 * pr) * 128] = y0[0] + y0[1];
                Sa = (Sa * LO2(Wv[q][1]) + LO2(KPv[q][1]) * v1) - LO2(BBv[q][1]) * sa1;
                Sb = (Sb * HI2(Wv[q][1]) + HI2(KPv[q][1]) * v1) - HI2(BBv[q][1]) * sa1;
                const f32x2 y1 = Sa * LO2(Rv[q][1]) + Sb * HI2(Rv[q][1]);
                yp[(2 * pr + 1) * 128] = y1[0] + y1[1];
            }
#undef LO2
#undef HI2
#undef SLOAD
        } else if (is_prep) {
            if (c + 1 < nch) { prep_compute(P, lds + ((c + 1) & 1) * SC_BUFB, st, cg4, kkc, kac);
                if (c + 3 < nch) prep_load(P, Rb, Kb, Vb, Ab, Wb, poff + (size_t)(c + 3) * SC_STEPS * D);
                const PrepRegs T_ = P; P = P2; P2 = T_; }
        } else if (is_red && c > 0) {
            const LAS float* ypb = (const LAS float*)(lds + SC_YOFF + ((c - 1) & 1) * 16384);
#pragma unroll
            for (int i = 0; i < 2; ++i) { const int o = lane + 64 * i, stp = (wave - 4) * 16 + (o >> 3), r8 = o & 7;
                const LAS f32x4* pp = (const LAS f32x4*)(ypb + (stp * 2 + (r8 >> 2)) * 64 + (r8 & 3) * 16);
                const f32x4 p0 = pp[0], p1 = pp[1], p2 = pp[2], p3 = pp[3];
                const f32x4 t = (p0 + p1) + (p2 + p3);
                Y[(size_t)(tok0 + (c - 1) * SC_STEPS + stp) * D + h * 64 + rg * 8 + r8] = (bf16)f2bf((t[0] + t[1]) + (t[2] + t[3])); }
        }
        __syncthreads();
    }
    if (is_red) {
        const LAS float* ypb = (const LAS float*)(lds + SC_YOFF + ((nch - 1) & 1) * 16384);
#pragma unroll
        for (int i = 0; i < 2; ++i) { const int o = lane + 64 * i, stp = (wave - 4) * 16 + (o >> 3), r8 = o & 7;
            const LAS f32x4* pp = (const LAS f32x4*)(ypb + (stp * 2 + (r8 >> 2)) * 64 + (r8 & 3) * 16);
            const f32x4 p0 = pp[0], p1 = pp[1], p2 = pp[2], p3 = pp[3];
            const f32x4 t = (p0 + p1) + (p2 + p3);
            Y[(size_t)(tok0 + (nch - 1) * SC_STEPS + stp) * D + h * 64 + rg * 8 + r8] = (bf16)f2bf((t[0] + t[1]) + (t[2] + t[3])); }
    }
    if (is_scan) *(f32x4*)(sT + (size_t)vrow * 64 + kq * 4) = (f32x4){Sa[0], Sa[1], Sb[0], Sb[1]};
    __syncthreads();
}
__device__ __forceinline__ void scan_phase(const Args& a, LAS unsigned char* lds, int wave, int lane, int vcu, int G) {
    for (int it = vcu; it < 256 + 2048; it += G) {
        if (it < 256) { const int bh = it >> 3, rg = it & 7, b = bh >> 4, h = bh & 15;
            scan_item(a, lds, wave, lane, b * 8192, 8192, h, rg, nullptr, a.out + O_WKVP + (size_t)bh * 4096, false);
        } else { const int j = it - 256; const int rg = j >> 8, bh = j & 255, b = bh >> 4, h = bh & 15;
            scan_item(a, lds, wave, lane, NP + b * 64, 64, h, rg, a.in[4] + (size_t)bh * 4096, a.out + O_WKVS + (size_t)bh * 4096, (G == 256) && rg > 0); }
    }
}
__device__ __forceinline__ void ld16bf(float (&o)[16], const bf16* p) {
    const v4u w0 = *(const v4u*)p, w1 = *(const v4u*)(p + 8);
    o[0] = bflo(w0.x); o[1] = bfhi(w0.x); o[2] = bflo(w0.y); o[3] = bfhi(w0.y); o[4] = bflo(w0.z); o[5] = bfhi(w0.z); o[6] = bflo(w0.w); o[7] = bfhi(w0.w);
    o[8] = bflo(w1.x); o[9] = bfhi(w1.x); o[10] = bflo(w1.y); o[11] = bfhi(w1.y); o[12] = bflo(w1.z); o[13] = bfhi(w1.z); o[14] = bflo(w1.w); o[15] = bfhi(w1.w);
}
__device__ __forceinline__ void ld16f(float (&o)[16], const float* p) {
#pragma unroll
    for (int j = 0; j < 4; ++j) { const f32x4 v = *(const f32x4*)(p + 4 * j); o[4 * j] = v[0]; o[4 * j + 1] = v[1]; o[4 * j + 2] = v[2]; o[4 * j + 3] = v[3]; }
}
__device__ __forceinline__ void st16bf(bf16* p, const float (&o)[16]) {
    *(v4u*)p = (v4u){pk2(o[0], o[1]), pk2(o[2], o[3]), pk2(o[4], o[5]), pk2(o[6], o[7])};
    *(v4u*)(p + 8) = (v4u){pk2(o[8], o[9]), pk2(o[10], o[11]), pk2(o[12], o[13]), pk2(o[14], o[15])};
}
__device__ __forceinline__ void postscan_phase(const Args& a, int gw, int NGW, int lane) {
    unsigned char* ws = a.ws;
    const bf16* Rb = (const bf16*)(ws + WS_R); const bf16* Kb = (const bf16*)(ws + WS_K); const bf16* Vb = (const bf16*)(ws + WS_V); const bf16* Gb = (const bf16*)(ws + WS_G); const bf16* Ab = (const bf16*)(ws + WS_A2);
    const bf16* Y = (const bf16*)(ws + WS_Y); bf16* A = (bf16*)(ws + WS_A);
    float ka[16], rk[16], lw[16], lb[16];
    ld16f(ka, a.in[24] + lane * 16); ld16f(rk, a.in[25] + lane * 16); ld16f(lw, a.in[26] + lane * 16); ld16f(lb, a.in[27] + lane * 16);
    for (int row = gw; row < NTOK; row += NGW) {
        const size_t off = (size_t)row * D + lane * 16;
        float y[16], r[16], k[16], v[16], g[16], av[16];
        ld16bf(y, Y + off); ld16bf(r, Rb + off); ld16bf(k, Kb + off); ld16bf(v, Vb + off); ld16bf(g, Gb + off); ld16bf(av, Ab + off);
        float s = 0.f, bd = 0.f;
#pragma unroll
        for (int i = 0; i < 16; ++i) { s += y[i]; bd += r[i] * (k[i] * ((av[i] - 1.f) * ka[i] + 1.f)) * rk[i]; }
        s += __shfl_xor(s, 1); s += __shfl_xor(s, 2); bd += __shfl_xor(bd, 1); bd += __shfl_xor(bd, 2);
        const float mean = s * (1.f / 64.f); float q = 0.f;
#pragma unroll
        for (int i = 0; i < 16; ++i) { y[i] -= mean; q += y[i] * y[i]; }
        q += __shfl_xor(q, 1); q += __shfl_xor(q, 2);
        const float rstd = 1.f / sqrtf(q * (1.f / 64.f) + GN_EPS);
        float o[16];
#pragma unroll
        for (int i = 0; i < 16; ++i) o[i] = (y[i] * rstd * lw[i] + lb[i] + bd * v[i]) * g[i];
        st16bf(A + off, o);
    }
}

__device__ __forceinline__ void conv_v_early(const Args& a, int wv, int nw, int lane) {
    bf16* VSB = (bf16*)(a.ws + WS_VSB);
    for (int r = wv; r < 16 * PAST; r += 2 * nw) {
        const int r1 = r + nw; const bool has1 = r1 < 16 * PAST;
        f32x4 x[4], y[4]; ld_row_nt(x, a.in[7] + (size_t)r * D, lane); if (has1) ld_row_nt(y, a.in[7] + (size_t)r1 * D, lane);
        bf16* dst = VSB + ((size_t)(r >> 11) * KS_ROWS + (r & 2047)) * D;
#pragma unroll
        for (int j = 0; j < 4; ++j) *(v2u*)(dst + 4 * lane + 256 * j) = (v2u){pk2(x[j][0], x[j][1]), pk2(x[j][2], x[j][3])};
        if (has1) { bf16* dst1 = VSB + ((size_t)(r1 >> 11) * KS_ROWS + (r1 & 2047)) * D;
#pragma unroll
            for (int j = 0; j < 4; ++j) *(v2u*)(dst1 + 4 * lane + 256 * j) = (v2u){pk2(y[j][0], y[j][1]), pk2(y[j][2], y[j][3])}; }
    }
}
__device__ __forceinline__ void conv_phase(const Args& a, int gw, int NGW, int lane, bool v_done) {
    unsigned char* ws = a.ws; bf16* KSB = (bf16*)(ws + WS_KSB); bf16* VSB = (bf16*)(ws + WS_VSB); bf16* QS = (bf16*)(ws + WS_QS);
    const int nconv = (v_done ? 1 : 2) * 16 * PAST;
    for (int it = gw; it < nconv; it += 2 * NGW) {
        const int it1 = it + NGW; const bool has1 = it1 < nconv;
        const int kv = it >= 16 * PAST, r = it - kv * 16 * PAST, kv1 = it1 >= 16 * PAST, r1 = it1 - kv1 * 16 * PAST;
        f32x4 x[4], y[4]; ld_row_nt(x, (kv ? a.in[7] : a.in[6]) + (size_t)r * D, lane); if (has1) ld_row_nt(y, (kv1 ? a.in[7] : a.in[6]) + (size_t)r1 * D, lane);
        bf16* dst = (kv ? VSB : KSB) + ((size_t)(r >> 11) * KS_ROWS + (r & 2047)) * D;
#pragma unroll
        for (int j = 0; j < 4; ++j) *(v2u*)(dst + 4 * lane + 256 * j) = (v2u){pk2(x[j][0], x[j][1]), pk2(x[j][2], x[j][3])};
        if (has1) { bf16* dst1 = (kv1 ? VSB : KSB) + ((size_t)(r1 >> 11) * KS_ROWS + (r1 & 2047)) * D;
#pragma unroll
            for (int j = 0; j < 4; ++j) *(v2u*)(dst1 + 4 * lane + 256 * j) = (v2u){pk2(y[j][0], y[j][1]), pk2(y[j][2], y[j][3])}; }
    }
    for (int it = gw; it < 2 * 16 * 64 + 16 * 192; it += NGW) {
        bf16* dst;
        if (it < 2048) { const int kv = it >> 10, r = it & 1023, b = r >> 6, t = r & 63; dst = (kv ? VSB : KSB) + ((size_t)b * KS_ROWS + PAST + 64 + t) * D; }
        else { const int r = it - 2048, b = r / 192, q = r % 192; dst = QS + ((size_t)b * QS_ROWS + (q < 128 ? q : q + 64)) * D; }
#pragma unroll
        for (int j = 0; j < 4; ++j) *(v2u*)(dst + 4 * lane + 256 * j) = (v2u){0u, 0u};
    }
}

__device__ __forceinline__ void attn_phase_all(const Args& a, unsigned char* lds_generic, int vcu, int G) {
    using abf = attn_body::bf16; unsigned char* ws = a.ws;
    const abf* QP = (const abf*)(ws + WS_QP); const abf* QS = (const abf*)(ws + WS_QS); const abf* KP = (const abf*)(ws + WS_KP); const abf* VP = (const abf*)(ws + WS_VP);
    const abf* KSB = (const abf*)(ws + WS_KSB); const abf* VSB = (const abf*)(ws + WS_VSB); abf* OS = (abf*)(ws + WS_OS);
    for (int v = vcu; v < 256; v += G) {
        const int bh = v >> 3, s = v & 7;
        for (int i = 0; i < 10; ++i) {
            if (i < 8) {
                const int bhp = (i < 4) ? bh : bh + 32, b = bhp >> 5, hp = bhp & 31; const int i4 = i & 3;
                const int qb = (i4 == 0) ? s : (i4 == 1) ? 15 - s : (i4 == 2) ? 16 + s : 31 - s;
                const int h = hp >> 2, c = (hp >> 1) & 1, vh = hp & 1; const int qcol = (h * 2 + c) * 64, vcol = h * 128 + vh * 64;
                const size_t r0 = (size_t)b * 8192;
                attn_body::attn_unit<8,false>(QP + (r0 + qb * 256) * 1024 + qcol, KP + r0 * 1024 + qcol, VP + r0 * 1024 + vcol, (abf*)(ws + (b ? WS_OP1 : WS_OP0)) + (size_t)(qb * 256) * 2048 + hp * 64, 4 * qb + 4, (char*)lds_generic);
            } else {
                const int u = 2 * v + (i - 8), b = u >> 5, hp = u & 31;
                const int h = hp >> 2, c = (hp >> 1) & 1, vh = hp & 1; const int qcol = (h * 2 + c) * 64, vcol = h * 128 + vh * 64;
                attn_body::attn_unit<8,true>(QS + (size_t)b * QS_ROWS * 1024 + qcol, KSB + (size_t)b * KS_ROWS * 1024 + qcol, VSB + (size_t)b * KS_ROWS * 1024 + vcol, OS + (size_t)b * QS_ROWS * 2048 + hp * 64, 34, (char*)lds_generic);
            }
        }
    }
}
__device__ __forceinline__ void combine_phase(const Args& a, int gw, int NGW, int lane) {
    unsigned char* ws = a.ws; const bf16* OS = (const bf16*)(ws + WS_OS); bf16* A = (bf16*)(ws + WS_A);
    const float* lp = a.in[34];
    const float lam = __builtin_expf(wave_sum(lp[lane] * lp[64 + lane])) - __builtin_expf(wave_sum(lp[128 + lane] * lp[192 + lane])) + LAM_INIT;
    const int h = lane >> 3, dv0 = (lane & 7) * 16;
    float g[16]; ld16f(g, a.in[35] + dv0);
    for (int row = gw; row < NTOK; row += NGW) {
        const bool smp = row >= NP; const int rs = row - NP;
        const bf16* src = smp ? OS + ((size_t)(rs >> 6) * QS_ROWS + 128 + (rs & 63)) * 2048 : (const bf16*)(ws + ((row >> 13) ? WS_OP1 : WS_OP0)) + (size_t)(row & 8191) * 2048;
        float o0[16], o1[16]; ld16bf(o0, src + h * 256 + dv0); ld16bf(o1, src + h * 256 + 128 + dv0);
        float q = 0.f;
#pragma unroll
        for (int i = 0; i < 16; ++i) { o0[i] -= lam * o1[i]; q += o0[i] * o0[i]; }
        q += __shfl_xor(q, 1); q += __shfl_xor(q, 2); q += __shfl_xor(q, 4);
        const float rstd = 1.f / sqrtf(q * (1.f / 128.f) + NORM_EPS) * (1.f - LAM_INIT);
#pragma unroll
        for (int i = 0; i < 16; ++i) o0[i] = o0[i] * rstd * g[i];
        st16bf(A + (size_t)row * D + h * 128 + dv0, o0);
    }
}

#define XB_TMO      128
#define XB_XCNT(j)  (256  + 64 * (j))
#define XB_XSUB(j)  (1280 + 64 * (j))
#define XB_XGEN(j)  (2304 + 64 * (j))
#define XB_TOP      3328
#define XB_TOPGEN   3392
#define XCD_BAR_WORDS 3456
#define XB_SPIN_CAP (1u << 18)

__device__ __forceinline__ unsigned xb_ld(unsigned* p)              { return __hip_atomic_load(p, __ATOMIC_RELAXED, __HIP_MEMORY_SCOPE_AGENT); }
__device__ __forceinline__ unsigned xb_add(unsigned* p, unsigned v) { return __hip_atomic_fetch_add(p, v, __ATOMIC_RELAXED, __HIP_MEMORY_SCOPE_AGENT); }
__device__ __forceinline__ unsigned xb_xcc_id() { return (unsigned)__builtin_amdgcn_s_getreg((3 << 11) | 20) & 0xFu; }
#define XB_SPIN(cond, bar) do { unsigned _sp = 0; while (cond) { __builtin_amdgcn_s_sleep(1); \
    if ((++_sp & 255u) == 0u) { if (xb_ld(&(bar)[XB_TMO])) break; if (_sp > XB_SPIN_CAP) { atomicAdd(&(bar)[XB_TMO], 1u); break; } } } } while (0)

struct XcdBarrier {
    unsigned* bar; unsigned x;
    volatile LAS unsigned* st;
};

__device__ __forceinline__ XcdBarrier xcd_barrier_post(unsigned* bar, volatile LAS unsigned* st) {
    XcdBarrier b; b.bar = bar; b.x = xb_xcc_id(); b.st = st;
    if (threadIdx.x == 0) (void)xb_add(&bar[XB_XCNT(b.x)], 1u);
    return b;
}
__device__ __forceinline__ void xcd_barrier_complete(unsigned* bar, unsigned x, unsigned& nloc, unsigned& nx) {
    const unsigned G = gridDim.x * gridDim.y * gridDim.z;
    unsigned sum, cnt, mine, sp = 0u;
    for (;;) {
        sum = 0u; cnt = 0u; mine = 0u;
#pragma unroll
        for (unsigned j = 0; j < 16; ++j) { const unsigned c = xb_ld(&bar[XB_XCNT(j)]); sum += c; cnt += (c > 0u) ? 1u : 0u; mine = (j == x) ? c : mine; }
        if (sum == G) break;
        __builtin_amdgcn_s_sleep(1);
        if ((++sp & 255u) == 0u) { if (xb_ld(&bar[XB_TMO])) break; if (sp > XB_SPIN_CAP) { atomicAdd(&bar[XB_TMO], 1u); break; } }
    }
    nloc = mine > 0u ? mine : 1u; nx = cnt > 0u ? cnt : 1u;
}

__device__ __forceinline__ void xcd_barrier(const XcdBarrier& b) {
    asm volatile("s_waitcnt vmcnt(0)" ::: "memory");
    __syncthreads();
    if (threadIdx.x == 0) {
        unsigned* bar = b.bar;
        __builtin_amdgcn_s_waitcnt(0);
        unsigned nloc = b.st[0], nx = b.st[1];
        if (nloc == 0u) { xcd_barrier_complete(bar, b.x, nloc, nx); b.st[0] = nloc; b.st[1] = nx; }
        const unsigned old = xb_add(&bar[XB_XSUB(b.x)], 1u);
        const unsigned gen = old / nloc;
        if (old + 1u == (gen + 1u) * nloc) {
            __builtin_amdgcn_fence(__ATOMIC_RELEASE, "agent");
            asm volatile("s_waitcnt vmcnt(0)" ::: "memory");
            const unsigned og = xb_add(&bar[XB_TOP], 1u);
            const unsigned tg = og / nx;
            if (og + 1u == (tg + 1u) * nx) xb_add(&bar[XB_TOPGEN], 1u);
            else XB_SPIN(xb_ld(&bar[XB_TOPGEN]) == tg, bar);
            __builtin_amdgcn_fence(__ATOMIC_ACQUIRE, "agent");
            xb_add(&bar[XB_XGEN(b.x)], 1u);
            asm volatile("s_waitcnt vmcnt(0)" ::: "memory");
        } else {
            XB_SPIN(xb_ld(&bar[XB_XGEN(b.x)]) == gen, bar);
            __builtin_amdgcn_fence(__ATOMIC_ACQUIRE, "agent");
            asm volatile("s_waitcnt vmcnt(0)" ::: "memory");
        }
    }
    __syncthreads();
}

constexpr int CW_BAR = 4096; constexpr int MISC_OFF = 131072 + 320;
enum { NPHASE = 26 };
#ifndef DBG_HI
#define DBG_HI NPHASE
#endif
__global__ void __launch_bounds__(NWAVES * 64) mega_fwd(Args a) {
    extern __shared__ __attribute__((aligned(16))) unsigned char lds[];
    cg::grid_group grid = cg::this_grid();
    LAS unsigned char* L = (LAS unsigned char*)lds;
    const int tid = threadIdx.x, lane = tid & 63, wave = __builtin_amdgcn_readfirstlane(tid >> 6);
    const int G = gridDim.x; const int bx = blockIdx.x; const int vcu = (G % 8 == 0) ? (bx % 8) * (G / 8) + bx / 8 : bx;
    const int gw = vcu * NWAVES + wave, NGW = G * NWAVES;
    unsigned char* ws = a.ws; bf16* WB = (bf16*)(ws + WS_W);
    const int lo = a.ph_lo, hi = a.ph_hi;
    volatile LAS unsigned* MISC = (volatile LAS unsigned*)(L + MISC_OFF);
    if (tid < 32) MISC[tid] = 0u;
    __syncthreads();
    XcdBarrier bar = xcd_barrier_post((unsigned*)ws + CW_BAR, MISC + 8);
    grid.sync();
    const bf16* Abuf = (const bf16*)(ws + WS_A);
#define PH(k) if (lo <= (k) && (k) < hi)
#define SYNC(k) do { if ((k) + 1 < hi) { xcd_barrier(bar); } } while (0)
#define RUN_GEMM(MODE, Aptr, Bptr, NN, KK, cofs) do { pg8::Gemm g{Aptr, Bptr, NTOK, NN, KK, KK}; pg8::StaticOrder S; S.init(NTOK, NN, G, (bx + (cofs)) % G); \
        pg8::gemm_phase<EpiG<MODE>, pg8::StaticOrder, true, true>(L, g, S, E); } while (0)
#define FFN_IN(k, f) PH(k) { if (EN_GEMM) { EpiG<EM_H> E{ws, nullptr, nullptr, nullptr}; RUN_GEMM(EM_H, Abuf, WB + WE_IN + (size_t)(f) * 5632 * 1024, 5632, 1024, 0); } SYNC(k); }
#define RUN_SPLIT(Aptr, Bptr, KK, PP) do { { EpiG<EM_RAW> E{ws, (float*)(ws + WS_RAW), nullptr, nullptr}; pg8::Gemm g{Aptr, Bptr, NP, 1024, KK, KK}; pg8::StaticOrder S; S.init(NP, 1024, G, bx); \
          pg8::gemm_phase<EpiG<EM_RAW>, pg8::StaticOrder, true, true>(L, g, S, E); } \
        { EpiG<EM_ATOM> E{ws, (float*)(ws + WS_PART), nullptr, nullptr}; pg8::Gemm g{(Aptr) + (size_t)NP * (KK), Bptr, NS, 1024, (KK) / (PP), KK}; pg8::SplitOrder S{PP, (KK) / (PP), G, bx}; \
          pg8::gemm_phase<EpiG<EM_ATOM>, pg8::SplitOrder, true, true>(L, g, S, E); } } while (0)
#define ZERO_RAW_SAMPLE() do { v4u* z_ = (v4u*)(ws + WS_RAW + (size_t)NP * D * 4); for (int i_ = gw * 64 + lane; i_ < NS * D / 4; i_ += NGW * 64) z_[i_] = (v4u){0u, 0u, 0u, 0u}; } while (0)
#define FFN_OUT(k, f) PH(k) { if (EN_GEMM) { RUN_SPLIT((const bf16*)(ws + WS_H), WB + WE_OUT + (size_t)(f) * 1024 * DFF, DFF, 11); } SYNC(k); }
#define PROJ_RAW(k, Woff) PH(k) { if (EN_GEMM) { RUN_SPLIT(Abuf, WB + (Woff), 1024, 4); } SYNC(k); }
    PH(0) { if (EN_P0) p0_phase(a, L, tid, wave, lane, vcu, G); SYNC(0); }
    PH(1) { rowpass<0>(a, gw, NGW, lane); SYNC(1); }
    FFN_IN(2, 0)
    FFN_OUT(3, 0)
    PH(4) { rowpass<1>(a, gw, NGW, lane); SYNC(4); }
    PH(5) { if (EN_GEMM) { EpiG<EM_R1> E{ws, nullptr, nullptr, nullptr}; RUN_GEMM(EM_R1, Abuf, WB + WE_RKV, 3328, 2048, 0); }
             if (G == 256 && bx >= 116) conv_v_early(a, (bx - 116) * NWAVES + wave, 140 * NWAVES, lane);
             SYNC(5); }
    PH(6) { if (EN_GEMM) { EpiG<EM_R2> E{ws, (float*)(ws + WS_A), a.in[15], a.in[18]}; RUN_GEMM(EM_R2, (const bf16*)(ws + WS_LORA), WB + WE_L2, 3072, 256, 0); } SYNC(6); }
    PH(7) { if (EN_SCAN) scan_phase(a, L, wave, lane, vcu, G); SYNC(7); }
    PH(8) { if (EN_POST) postscan_phase(a, gw, NGW, lane); SYNC(8); }
    PROJ_RAW(9, WE_WO)
    PH(10) { rowpass<2>(a, gw, NGW, lane); SYNC(10); }
    FFN_IN(11, 1)
    FFN_OUT(12, 1)
    PH(13) { rowpass<3>(a, gw, NGW, lane); SYNC(13); }
    FFN_IN(14, 2)
    FFN_OUT(15, 2)
    PH(16) { rowpass<4>(a, gw, NGW, lane); SYNC(16); }
    PH(17) { if (G != 256) conv_phase(a, gw, NGW, lane, false);
             if (EN_GEMM) { EpiG<EM_KV> E{ws, a.out, nullptr, nullptr}; RUN_GEMM(EM_KV, (const bf16*)(ws + WS_A2), WB + WE_KV, 2048, 1024, 0); } }
    PH(18) { if (EN_GEMM) { EpiG<EM_Q> E{ws, nullptr, nullptr, nullptr}; RUN_GEMM(EM_Q, Abuf, WB + WE_Q, 1024, 1024, 128); }
             if (G == 256 && !(bx < 32 || (bx >= 128 && bx < 144))) { const int rk = (bx < 128) ? bx - 32 : 96 + (bx - 144); conv_phase(a, rk * NWAVES + wave, 208 * NWAVES, lane, true); }
             SYNC(18); }
    PH(19) { if (EN_ATTN) attn_phase_all(a, lds, vcu, G); SYNC(19); }
    PH(20) { if (EN_COMB) combine_phase(a, gw, NGW, lane); SYNC(20); }
    PROJ_RAW(21, WE_DO)
    PH(22) { rowpass<5>(a, gw, NGW, lane); SYNC(22); }
    FFN_IN(23, 3)
    FFN_OUT(24, 3)
    PH(25) { rowpass<6>(a, gw, NGW, lane); }
#ifdef DBG_OFF0
    xcd_barrier(bar);
    { const v4u* s0 = (const v4u*)(ws + (size_t)DBG_OFF0); v4u* d0 = (v4u*)(a.out + O_KP); const size_t n0 = (size_t)DBG_BYTES0 / 16;
      for (size_t i = (size_t)gw * 64 + lane; i < n0; i += (size_t)NGW * 64) d0[i] = s0[i];
      const v4u* s1 = (const v4u*)(ws + (size_t)DBG_OFF1); v4u* d1 = d0 + n0; const size_t n1 = (size_t)DBG_BYTES1 / 16;
      for (size_t i = (size_t)gw * 64 + lane; i < n1; i += (size_t)NGW * 64) d1[i] = s1[i]; }
#endif
}

extern "C" void kernel_launch(void* const* d_in, const int* in_sizes, int n_in, void* d_out, int out_size, void* d_ws, size_t ws_size, hipStream_t stream) {
    static int grid = 0;
    if (grid == 0) {
        if (n_in != 37 || (size_t)out_size != O_TOTAL || ws_size < WS_END) { fprintf(stderr, "kernel_launch: unexpected problem: n_in %d out %d ws %zu (need %zu)\n", n_in, out_size, ws_size, (size_t)WS_END); grid = -1; return; }
        int dev = 0, cus = 0, per_cu = 0;
        if (hipGetDevice(&dev) != hipSuccess || hipDeviceGetAttribute(&cus, hipDeviceAttributeMultiprocessorCount, dev) != hipSuccess) { grid = -1; return; }
        if (hipFuncSetAttribute((const void*)mega_fwd, hipFuncAttributeMaxDynamicSharedMemorySize, LDS_BYTES) != hipSuccess) { fprintf(stderr, "kernel_launch: hipFuncSetAttribute failed\n"); grid = -1; return; }
        if (hipOccupancyMaxActiveBlocksPerMultiprocessor(&per_cu, (const void*)mega_fwd, NWAVES * 64, LDS_BYTES) != hipSuccess || per_cu < 1) { fprintf(stderr, "kernel_launch: occupancy query failed (%d)\n", per_cu); (void)hipGetLastError(); grid = -1; return; }
        grid = cus;
    }
    if (grid < 0) return;
    if (hipMemsetAsync(d_ws, 0, 1u << 20, stream) != hipSuccess) { fprintf(stderr, "kernel_launch: memset failed\n"); return; }
    Args a{};
    for (int i = 0; i < 37; ++i) a.in[i] = (const float*)d_in[i];
    a.out = (float*)d_out; a.ws = (unsigned char*)d_ws; a.ph_lo = 0; a.ph_hi = DBG_HI;
    void* args[] = {&a};
    hipError_t e = hipLaunchCooperativeKernel((const void*)mega_fwd, dim3(grid), dim3(NWAVES * 64), args, LDS_BYTES, stream);
    if (e != hipSuccess) fprintf(stderr, "kernel_launch: cooperative launch failed: %s (grid %d)\n", hipGetErrorString(e), grid);
}
```

```cpp
#include <hip/hip_runtime.h>
#include <hip/hip_cooperative_groups.h>
#include <cstdio>
#include <cstdint>
__device__ __forceinline__ int opaque_tid() { int t = (int)threadIdx.x; asm volatile("" : "+v"(t)); return t; }
namespace pg8 {
#define PG8_LAS __attribute__((address_space(3)))
typedef unsigned short bf16_t;
typedef short bf16x8 __attribute__((ext_vector_type(8)));
typedef float f32x4 __attribute__((ext_vector_type(4)));
typedef unsigned u32x4 __attribute__((ext_vector_type(4)));
constexpr int BM = 256, BK = 64, HALF = 128, HTB = HALF * BK * 2  , STAGE_BYTES = 8 * HTB, NXCD = 8, WGM = 8;

__host__ __device__ __forceinline__ int lds_byte(int r, int c) { const int st = (r >> 4) * 2 + (c >> 5), rr = r & 15, cc = c & 31, ob = rr * 64 + cc * 2; return st * 1024 + (ob ^ (((ob >> 9) & 1) << 5)); }
__host__ __device__ __forceinline__ void stage_rc(int b, int& R, int& C) { const int st = b / 1024, sb = b % 1024, swz = sb ^ (((sb >> 9) & 1) << 5); R = (st >> 1) * 16 + swz / 64; C = (st & 1) * 32 + (swz % 64) / 2; }
__host__ __device__ __forceinline__ int perm32(int rho) { const int n = rho >> 4, i = rho & 15; return 8 * (i >> 2) + 4 * n + (i & 3); }

struct Unit { int pm, pn, kofs; };
struct Gemm { const bf16_t* A; const bf16_t* Bt; int M, N, K, ld; };

struct StaticOrder {
    static constexpr bool OPAQUE_K = false;
    int nM, nN, nwg, G, c;
    __host__ __device__ void init(int M, int N, int G_, int c_) { nM = M / BM; nN = N / BM; nwg = nM * nN; G = G_; c = c_; }
    __host__ __device__ bool next(int i, Unit& u) const {
        const long L = (long)i * G + c; if (L >= nwg) return false;
        int wgid = (int)L; { const int q = nwg / NXCD, r = nwg % NXCD, xcd = wgid % NXCD, off = wgid / NXCD; wgid = (xcd < r ? xcd * (q + 1) : r * (q + 1) + (xcd - r) * q) + off; }
        const int nig = WGM * nN, gid = wgid / nig, fm = gid * WGM, gsz = (nM - fm) < WGM ? (nM - fm) : WGM;
        u.pm = fm + ((wgid % nig) % gsz); u.pn = (wgid % nig) / gsz; u.kofs = 0; return true;
    }
    __device__ __forceinline__ void a_ready(const Unit&) const {}
    __device__ __forceinline__ void done(const Unit&) const {}
};

struct SplitOrder {
    static constexpr bool OPAQUE_K = true;
    int P, kpart, G, c;
    __host__ __device__ bool next(int i, Unit& u) const { const int L = i * G + c; if (L >= 16 * P) return false; const int kp = L >> 4, r = L & 15; u.pm = r >> 2; u.pn = r & 3; u.kofs = kp * kpart; return true; }
    __device__ __forceinline__ void a_ready(const Unit&) const {}
    __device__ __forceinline__ void done(const Unit&) const {}
};
__device__ __forceinline__ unsigned cvt_pk_bf16(float lo, float hi) { unsigned r; asm volatile("v_cvt_pk_bf16_f32 %0, %1, %2" : "=v"(r) : "v"(lo), "v"(hi)); return r; }
template <class Epi, class Sched, bool ALIGN_EPI = false, bool SP2 = false>
__device__ __forceinline__ void gemm_phase(PG8_LAS unsigned char* lds, const Gemm g, const Sched& S, const Epi& E) {
    const int tid = opaque_tid(), wid = __builtin_amdgcn_readfirstlane(tid >> 6), lane = tid & 63, wr = wid >> 2, wc = wid & 3, fr = lane & 15, fq = lane >> 4;
    int nt = g.K / BK; if constexpr (Sched::OPAQUE_K) asm volatile("" : "+s"(nt));
    const int K = g.ld;
    unsigned voffA[2], voffB[2];
#pragma unroll
    for (int i = 0; i < 2; ++i) { int R, C; stage_rc(tid * 16 + i * 8192, R, C); const int Rb = Epi::PERM ? ((R & ~31) + perm32(R & 31)) : R;
        voffA[i] = (unsigned)(R * K + C) * 2u; voffB[i] = (unsigned)(Rb * K + C) * 2u; }
    const size_t kstep = (size_t)(BK * 2);
    const size_t hstep = (size_t)HALF * K * 2;
    const size_t tstep = 2 * hstep;
    const unsigned ldsw = (unsigned)wid * 1024u;
    const int aoff = lds_byte(wr * 64 + fr, fq * 8), boff = lds_byte(wc * 32 + fr, fq * 8);
#define PG8_SA(b, h) (((b) * 2 + (h)) * HTB)
#define PG8_SB(b, h) ((4 + (b) * 2 + (h)) * HTB)
#define PG8_STAGE(bufoff, gbase, voff) do { _Pragma("unroll") for (int _i = 0; _i < 2; ++_i) \
        __builtin_amdgcn_global_load_lds((const unsigned*)((const char*)(gbase) + (voff)[_i]), (PG8_LAS unsigned*)(lds + (bufoff) + ldsw + _i * 8192), 16, 0, 0); } while (0)
#define PG8_LDA(dst, b, h) do { _Pragma("unroll") for (int m = 0; m < 4; ++m) _Pragma("unroll") for (int k = 0; k < 2; ++k) dst[m][k] = *(const PG8_LAS bf16x8*)(lds + PG8_SA(b, h) + aoff + m * 2048 + k * 1024); } while (0)
#define PG8_LDB(dst, b, h) do { _Pragma("unroll") for (int n = 0; n < 2; ++n) _Pragma("unroll") for (int k = 0; k < 2; ++k) dst[n][k] = *(const PG8_LAS bf16x8*)(lds + PG8_SB(b, h) + boff + n * 2048 + k * 1024); } while (0)
#define PG8_MMA(ai, bj, At, Bt) do { __builtin_amdgcn_s_setprio(1); _Pragma("unroll") for (int m = 0; m < 4; ++m) _Pragma("unroll") for (int n = 0; n < 2; ++n) _Pragma("unroll") for (int k = 0; k < 2; ++k) \
        acc[ai][bj][m][n] = __builtin_amdgcn_mfma_f32_16x16x32_bf16(Bt[n][k], At[m][k], acc[ai][bj][m][n], 0, 0, 0); __builtin_amdgcn_s_setprio(0); } while (0)
#define PG8_WAIT_V(n) asm volatile("s_waitcnt vmcnt(" #n ")" ::: "memory")
#define PG8_WAIT_L(n) asm volatile("s_waitcnt lgkmcnt(" #n ")" ::: "memory")
#define PG8_BAR __builtin_amdgcn_s_barrier()
#define PG8_SCHED __builtin_amdgcn_sched_barrier(0)
    Unit cur, nxt; int ui = 0;
    if (!S.next(0, cur)) return;
    f32x4 acc[2][2][4][2];
#pragma unroll
    for (int a = 0; a < 2; ++a)
#pragma unroll
        for (int b = 0; b < 2; ++b)
#pragma unroll
            for (int m = 0; m < 4; ++m)
#pragma unroll
                for (int n = 0; n < 2; ++n) acc[a][b][m][n] = (f32x4){0.f, 0.f, 0.f, 0.f};
    bf16x8 At[4][2], B0[2][2], B1[2][2];
    const char* cA = (const char*)g.A + (size_t)cur.pm * tstep + (size_t)cur.kofs * 2; const char* cB = (const char*)g.Bt + (size_t)cur.pn * tstep + (size_t)cur.kofs * 2;
    S.a_ready(cur);
    if constexpr (SP2) {
        PG8_STAGE(PG8_SB(0, 0), cB, voffB); PG8_STAGE(PG8_SB(0, 1), cB + hstep, voffB); PG8_STAGE(PG8_SA(0, 0), cA, voffA); PG8_STAGE(PG8_SA(0, 1), cA + hstep, voffA);
        if (wr == 1) PG8_BAR;
        PG8_WAIT_V(2); PG8_BAR;
        PG8_STAGE(PG8_SB(1, 0), cB + kstep, voffB); PG8_STAGE(PG8_SA(1, 0), cA + kstep, voffA); PG8_STAGE(PG8_SB(1, 1), cB + hstep + kstep, voffB);
        PG8_WAIT_V(6); PG8_BAR;
    } else {
        PG8_STAGE(PG8_SB(0, 0), cB, voffB); PG8_STAGE(PG8_SA(0, 0), cA, voffA); PG8_STAGE(PG8_SB(0, 1), cB + hstep, voffB); PG8_STAGE(PG8_SA(0, 1), cA + hstep, voffA);
        if (wr == 1) PG8_BAR;
        PG8_WAIT_V(4); PG8_BAR;
        PG8_STAGE(PG8_SB(1, 0), cB + kstep, voffB); PG8_STAGE(PG8_SA(1, 0), cA + kstep, voffA); PG8_STAGE(PG8_SB(1, 1), cB + hstep + kstep, voffB);
        PG8_WAIT_V(6); PG8_BAR;
    }
    for (;;) {
        const bool has_next = S.next(ui + 1, nxt);
        const char* nA = has_next ? (const char*)g.A + (size_t)nxt.pm * tstep + (size_t)nxt.kofs * 2 : cA; const char* nB = has_next ? (const char*)g.Bt + (size_t)nxt.pn * tstep + (size_t)nxt.kofs * 2 : cB;
        for (int t = 0; t < nt; t += 2) {
            const bool last = (t == nt - 2);
            const char* a1 = cA + (size_t)(t + 1) * kstep;
            const char* a2 = last ? nA : cA + (size_t)(t + 2) * kstep; const char* b2 = last ? nB : cB + (size_t)(t + 2) * kstep;
            const char* a3 = a2 + kstep; const char* b3 = b2 + kstep;
            if (last && has_next) S.a_ready(nxt);
            if constexpr (SP2) {
            PG8_LDB(B0, 0, 0); PG8_LDB(B1, 0, 1); PG8_SCHED; PG8_LDA(At, 0, 0); PG8_STAGE(PG8_SA(1, 1), a1 + hstep, voffA);
            PG8_WAIT_V(8); PG8_WAIT_L(0); PG8_BAR; PG8_MMA(0, 0, At, B0); PG8_MMA(0, 1, At, B1); PG8_BAR; PG8_SCHED;
            PG8_LDA(At, 0, 1); PG8_STAGE(PG8_SB(0, 0), b2, voffB); PG8_STAGE(PG8_SB(0, 1), b2 + hstep, voffB); PG8_STAGE(PG8_SA(0, 0), a2, voffA);
            PG8_WAIT_V(8); PG8_WAIT_L(0); PG8_BAR; PG8_MMA(1, 0, At, B0); PG8_MMA(1, 1, At, B1); PG8_BAR; PG8_SCHED;
            PG8_LDB(B0, 1, 0); PG8_LDB(B1, 1, 1); PG8_SCHED; PG8_LDA(At, 1, 0); PG8_STAGE(PG8_SA(0, 1), a2 + hstep, voffA);
            PG8_WAIT_V(8); PG8_WAIT_L(0); PG8_BAR; PG8_MMA(0, 0, At, B0); PG8_MMA(0, 1, At, B1); PG8_BAR; PG8_SCHED;
            PG8_LDA(At, 1, 1); PG8_STAGE(PG8_SB(1, 0), b3, voffB); PG8_STAGE(PG8_SB(1, 1), b3 + hstep, voffB); PG8_STAGE(PG8_SA(1, 0), a3, voffA);
            PG8_WAIT_V(8); PG8_WAIT_L(0); PG8_BAR; PG8_MMA(1, 0, At, B0); PG8_MMA(1, 1, At, B1); PG8_BAR; PG8_SCHED;
            } else {
            PG8_LDB(B0, 0, 0); PG8_SCHED; PG8_LDA(At, 0, 0); PG8_STAGE(PG8_SA(1, 1), a1 + hstep, voffA);
            PG8_WAIT_L(8); PG8_BAR; PG8_WAIT_L(0); PG8_MMA(0, 0, At, B0); PG8_BAR; PG8_SCHED;
            PG8_LDB(B1, 0, 1); PG8_STAGE(PG8_SB(0, 0), b2, voffB);
            PG8_BAR; PG8_WAIT_L(0); PG8_MMA(0, 1, At, B1); PG8_BAR;
            PG8_LDA(At, 0, 1); PG8_STAGE(PG8_SA(0, 0), a2, voffA);
            PG8_BAR; PG8_WAIT_L(0); PG8_MMA(1, 0, At, B0); PG8_BAR; PG8_SCHED;
            PG8_STAGE(PG8_SB(0, 1), b2 + hstep, voffB);
            PG8_WAIT_V(6); PG8_BAR; PG8_MMA(1, 1, At, B1); PG8_BAR;
            PG8_LDB(B0, 1, 0); PG8_SCHED; PG8_LDA(At, 1, 0); PG8_STAGE(PG8_SA(0, 1), a2 + hstep, voffA);
            PG8_WAIT_L(8); PG8_BAR; PG8_WAIT_L(0); PG8_MMA(0, 0, At, B0); PG8_BAR; PG8_SCHED;
            PG8_LDB(B1, 1, 1); PG8_STAGE(PG8_SB(1, 0), b3, voffB);
            PG8_BAR; PG8_WAIT_L(0); PG8_MMA(0, 1, At, B1); PG8_BAR;
            PG8_LDA(At, 1, 1); PG8_STAGE(PG8_SA(1, 0), a3, voffA);
            PG8_BAR; PG8_WAIT_L(0); PG8_MMA(1, 0, At, B0); PG8_BAR; PG8_SCHED;
            PG8_STAGE(PG8_SB(1, 1), b3 + hstep, voffB);
            PG8_WAIT_V(6); PG8_BAR; PG8_MMA(1, 1, At, B1); PG8_BAR;
            }
        }
        if constexpr (ALIGN_EPI) { if (wr == 0) PG8_BAR; }
        if constexpr (!Epi::AFTER_DRAIN) { E(acc, cur, wr, wc, fr, fq); S.done(cur); }
        if (!has_next) break;
#pragma unroll
        for (int a = 0; a < 2; ++a)
#pragma unroll
            for (int b = 0; b < 2; ++b)
#pragma unroll
                for (int m = 0; m < 4; ++m)
#pragma unroll
                    for (int n = 0; n < 2; ++n) acc[a][b][m][n] = (f32x4){0.f, 0.f, 0.f, 0.f};
        cur = nxt; cA = nA; cB = nB; ++ui;
        if constexpr (ALIGN_EPI) { if (wr == 1) PG8_BAR; }
    }
    PG8_WAIT_V(0);
    if constexpr (!ALIGN_EPI) { if (wr == 0) PG8_BAR; }
    PG8_BAR;
    if constexpr (Epi::AFTER_DRAIN) { E.fused(acc, cur, wr, wc, fr, fq, lds, wid, lane); S.done(cur); }
#undef PG8_SA
#undef PG8_SB
#undef PG8_STAGE
#undef PG8_LDA
#undef PG8_LDB
#undef PG8_MMA
#undef PG8_WAIT_V
#undef PG8_WAIT_L
#undef PG8_BAR
#undef PG8_SCHED
}
}
#include <hip/hip_bf16.h>
#include <cmath>
namespace attn_body {
using bf16=__hip_bfloat16;
using bf16x8=__attribute__((ext_vector_type(8)))short;
using s16x4=__attribute__((ext_vector_type(4)))short;
using f32x16=__attribute__((ext_vector_type(16)))float;
using u32x4=__attribute__((ext_vector_type(4)))unsigned;
constexpr int BATCH=2,NHEAD=16,SEQ=8192,D=64,DM=NHEAD*D;
constexpr int NW=8,QBLK=32,QB=QBLK*NW,KVBLK=64,NQB=SEQ/QB;
constexpr int ATTN_PITCH=DM, ATTN_UNIT_ROWS=QB;
__device__ __forceinline__ int crow(int r,int hi){return (r&3)+8*(r>>2)+4*hi;}
#define SBAR() __builtin_amdgcn_sched_barrier(0)
__device__ __forceinline__ void cmask(f32x16&p0,f32x16&p1,int jb,int qrel,int hi){
  const float NEG=-INFINITY; (void)hi;
  if(jb>(qrel>>6)){
  #pragma unroll
  for(int r=0;r<16;++r){p0[r]=NEG;p1[r]=NEG;} }
}

constexpr int NSLOT=3, SLOTB=8192;
constexpr int LDS_K=0, LDS_V=NSLOT*SLOTB, LDS_WS=2*NSLOT*SLOTB, LDS_OST=LDS_WS+NW*64*4, LDS_BYTES=LDS_OST+NW*4096;
constexpr float C2=0.125f*1.4426950408889634f;
__device__ __forceinline__ void glds16(const void*gsrc,unsigned lds_dst){unsigned keep;
  asm volatile("s_mov_b32 %0, m0\n\ts_mov_b32 m0, %2\n\ts_nop 0\n\tglobal_load_lds_dwordx4 %1, off\n\ts_mov_b32 m0, %0":"=&s"(keep):"v"(gsrc),"s"(lds_dst):"memory");}
__device__ __forceinline__ float max3f(float a,float b,float c){float r;asm("v_max3_f32 %0, %1, %2, %3":"=v"(r):"v"(a),"v"(b),"v"(c));return r;}
__device__ __forceinline__ float max2f(float a,float b){float r;asm("v_max_f32_e32 %0, %1, %2":"=v"(r):"v"(a),"v"(b));return r;}
__device__ __forceinline__ float fadd_s(float a,float b){float r;asm("v_add_f32_e32 %0, %1, %2":"=v"(r):"v"(a),"v"(b));return r;}
__device__ __forceinline__ float fsub_s(float a,float b){float r;asm("v_sub_f32_e32 %0, %1, %2":"=v"(r):"v"(a),"v"(b));return r;}
typedef float f32x2_t __attribute__((ext_vector_type(2))); typedef __bf16 bf16x2_t __attribute__((ext_vector_type(2)));
__device__ __forceinline__ unsigned cvtpk_s(float lo,float hi){f32x2_t v={lo,hi};bf16x2_t b=__builtin_convertvector(v,bf16x2_t);return __builtin_bit_cast(unsigned,b);}
#define WAIT_BAR(N) asm volatile("s_waitcnt vmcnt(" #N ") lgkmcnt(0)\n\ts_barrier":::"memory")

__device__ __forceinline__ void qkt(f32x16&p0,f32x16&p1,const char*Kslot,const bf16x8*qr,const f32x16&negm,int r32,int hi){
  const char*kb=Kslot+hi*1024+r32*16;
  #pragma unroll
  for(int d0=0;d0<4;++d0){
    const bf16x8 b0=*reinterpret_cast<const bf16x8*>(kb+d0*2048);
    const bf16x8 b1=*reinterpret_cast<const bf16x8*>(kb+d0*2048+512);
    if(d0==0){p0=__builtin_amdgcn_mfma_f32_32x32x16_bf16(b0,qr[0],negm,0,0,0);p1=__builtin_amdgcn_mfma_f32_32x32x16_bf16(b1,qr[0],negm,0,0,0);}
    else{p0=__builtin_amdgcn_mfma_f32_32x32x16_bf16(b0,qr[d0],p0,0,0,0);p1=__builtin_amdgcn_mfma_f32_32x32x16_bf16(b1,qr[d0],p1,0,0,0);}}
}
typedef __attribute__((address_space(3))) const char* lds_cptr;
typedef short v4i16_t __attribute__((ext_vector_type(4)));
__device__ __forceinline__ void kload8(bf16x8*kf,lds_cptr kp){
  kf[0]=*(const __attribute__((address_space(3))) bf16x8*)(kp);      kf[1]=*(const __attribute__((address_space(3))) bf16x8*)(kp+512);
  kf[2]=*(const __attribute__((address_space(3))) bf16x8*)(kp+2048); kf[3]=*(const __attribute__((address_space(3))) bf16x8*)(kp+2560);
  kf[4]=*(const __attribute__((address_space(3))) bf16x8*)(kp+4096); kf[5]=*(const __attribute__((address_space(3))) bf16x8*)(kp+4608);
  kf[6]=*(const __attribute__((address_space(3))) bf16x8*)(kp+6144); kf[7]=*(const __attribute__((address_space(3))) bf16x8*)(kp+6656);
}
__device__ __forceinline__ void kload2(bf16x8*kf,lds_cptr kp,int j){ kf[2*j]=*(const __attribute__((address_space(3))) bf16x8*)(kp+j*2048); kf[2*j+1]=*(const __attribute__((address_space(3))) bf16x8*)(kp+j*2048+512); }
__device__ __forceinline__ s16x4 vtr(lds_cptr p){ return __builtin_bit_cast(s16x4,__builtin_amdgcn_ds_read_tr16_b64_v4i16((__attribute__((address_space(3))) v4i16_t*)p)); }
__device__ __forceinline__ float rowmax(const f32x16&p0,const f32x16&p1){
  float a=max3f(p0[0],p0[1],p1[0]),b=max3f(p0[2],p0[3],p1[1]);a=max3f(a,p1[2],p1[3]);
  #pragma unroll
  for(int r=4;r<16;r+=4){a=max3f(a,p0[r],p0[r+1]);b=max3f(b,p0[r+2],p0[r+3]);a=max3f(a,p1[r],p1[r+1]);b=max3f(b,p1[r+2],p1[r+3]);}
  const float m=max2f(a,b);
  auto rr=__builtin_amdgcn_permlane32_swap(__float_as_uint(m),__float_as_uint(m),false,false);
  return max2f(__uint_as_float(rr[0]),__uint_as_float(rr[1]));
}
__device__ __forceinline__ void pv(f32x16*o,int vb,bf16x8 pa0,bf16x8 pa1,bf16x8 pa2,bf16x8 pa3){
  #pragma unroll
  for(int d0=0;d0<2;++d0){s16x4 lo[4],hi[4];
    #pragma unroll
    for(int ks=0;ks<4;++ks){
      asm volatile("ds_read_b64_tr_b16 %0,%1 offset:%c2":"=&v"(lo[ks]):"v"(vb),"i"(d0*4096+ks*1024):"memory");
      asm volatile("ds_read_b64_tr_b16 %0,%1 offset:%c2":"=&v"(hi[ks]):"v"(vb),"i"(d0*4096+ks*1024+512):"memory");}
    asm volatile("s_waitcnt lgkmcnt(0)":::"memory");SBAR();
    #define PK(k) (bf16x8){lo[k][0],lo[k][1],lo[k][2],lo[k][3],hi[k][0],hi[k][1],hi[k][2],hi[k][3]}
    o[d0]=__builtin_amdgcn_mfma_f32_32x32x16_bf16(pa0,PK(0),o[d0],0,0,0);
    o[d0]=__builtin_amdgcn_mfma_f32_32x32x16_bf16(pa1,PK(1),o[d0],0,0,0);
    o[d0]=__builtin_amdgcn_mfma_f32_32x32x16_bf16(pa2,PK(2),o[d0],0,0,0);
    o[d0]=__builtin_amdgcn_mfma_f32_32x32x16_bf16(pa3,PK(3),o[d0],0,0,0);
    #undef PK
  }
}

#ifndef ATTN_STORE16
#define ATTN_STORE16(p,v) (*(u32x4*)(p)=(v))
#endif
constexpr int OPITCH=2048;
template<int THRL,bool SMP> __device__ __forceinline__ void attn_unit(const bf16*Qu,const bf16*__restrict__ Kh,const bf16*__restrict__ Vh,bf16*Ou,const int NT,char*shm){
  const int tid=opaque_tid(),lane=tid&63,r32=lane&31,hi=lane>>5; const int wid=__builtin_amdgcn_readfirstlane(tid>>6);
  const bf16*Qw=Qu+(long)(wid*QBLK)*DM;
  const unsigned lds0=(unsigned)(uintptr_t)shm;
  float*wsf=(float*)(shm+LDS_WS)+wid*64;
  const bf16*ksrc=Kh+(long)lane*DM+wid*8;
  const bf16*vsrc=Vh+(long)(16*(wid&3)+(lane>>2))*DM+(wid>>2)*32+(lane&3)*8;
  const unsigned kdst=lds0+LDS_K+wid*1024, vdst=lds0+LDS_V+wid*1024;
  #define DMA_K(t,slot) glds16(ksrc+(long)(t)*KVBLK*DM,(unsigned)__builtin_amdgcn_readfirstlane(kdst+(slot)))
  #define DMA_V(t,slot) glds16(vsrc+(long)(t)*KVBLK*DM,(unsigned)__builtin_amdgcn_readfirstlane(vdst+(slot)))
  const int vb0=(int)(lds0+LDS_V)+((lane>>4)&1)*32+(lane&3)*8+(4*hi+((lane&15)>>2))*64;
  const char*Kbase=shm+LDS_K; bf16x8 kf[8];
  const lds_cptr shm3=(lds_cptr)shm; const lds_cptr kp0=shm3+LDS_K+hi*1024+r32*16; const lds_cptr vp0=shm3+LDS_V+((lane>>4)&1)*32+(lane&3)*8+(4*hi+((lane&15)>>2))*64;
  if(SMP&&!(wid==4||wid==5)){
    int sp_=0,sc_=0,sn_=SLOTB; (void)sp_;
    #define ROTS() do{sp_=sc_;sc_=sn_;sn_=(sn_==(NSLOT-1)*SLOTB)?0:sn_+SLOTB;}while(0)
    #define SKS(t,GK,GV) do{ if(GK){DMA_K((t)+3,sc_);} if(GV){DMA_V((t)+1,sn_);} }while(0)
    #define ENDS(tt) do{ if((tt)+3<NT){WAIT_BAR(2);} else if((tt)+2<NT){WAIT_BAR(1);} else {WAIT_BAR(0);} }while(0)
    DMA_K(0,0);DMA_V(0,0);DMA_K(1,SLOTB);
    DMA_K(2,2*SLOTB);
    WAIT_BAR(3);
    WAIT_BAR(0);
    DMA_K(3,0);DMA_V(1,SLOTB);
    ROTS();
    WAIT_BAR(2);
    int t=1;
    for(;t+5<NT;t+=2){ SKS(t,true,true); WAIT_BAR(2); ROTS(); SKS(t+1,true,true); WAIT_BAR(2); ROTS(); }
    for(;t+1<NT;t+=2){ SKS(t,(t+3<NT),(t+1<NT)); ENDS(t); ROTS(); SKS(t+1,(t+4<NT),(t+2<NT)); ENDS(t+1); ROTS(); }
    asm volatile("s_waitcnt lgkmcnt(0)\n\ts_barrier":::"memory");
    #undef ROTS
    #undef SKS
    #undef ENDS
    return;
  }
  DMA_K(0,0);DMA_V(0,0);DMA_K(1,SLOTB);
  bf16x8 qr[4];
  #pragma unroll
  for(int d0=0;d0<4;++d0)qr[d0]=*reinterpret_cast<const bf16x8*>(&Qw[(long)r32*DM+d0*16+hi*8]);
  float mhat=0.f,l_reg=0.f;f32x16 o[2];o[0]=f32x16{};o[1]=f32x16{};f32x16 negm=f32x16{};asm volatile("":"+v"(negm));
  const int qrel=wid*QBLK+r32;
  #define CMASK(P0,P1,t) do{int jb_=(t)-(NT-4); if(jb_>=0)cmask(P0,P1,jb_,qrel,hi);}while(0)
  bool resc=false;
  #define START(P0,P1) do{ const float rm=rowmax(P0,P1); resc=false; \
    { const float dl=rm; mhat=fadd_s(mhat,dl); \
      _Pragma("unroll") for(int r=0;r<16;++r){P0[r]=fsub_s(P0[r],dl);P1[r]=fsub_s(P1[r],dl);} \
      _Pragma("unroll") for(int r=0;r<16;++r)negm[r]=-mhat; asm volatile("":"+v"(negm)); } \
    _Pragma("unroll") for(int r=0;r<16;++r)P0[r]=__builtin_amdgcn_exp2f(P0[r]); }while(0)
  #define RESC() do{ if(resc){ asm volatile("s_waitcnt lgkmcnt(0)":::"memory"); \
      _Pragma("unroll") for(int d_=0;d_<2;++d_) _Pragma("unroll") for(int r=0;r<16;++r)o[d_][r]*=wsf[crow(r,hi)]; } }while(0)
  f32x16 pA0,pA1,pB0,pB1;
  int sl_prev=0,sl_cur=0,sl_next=SLOTB;
  #define ROT() do{sl_prev=sl_cur;sl_cur=sl_next;sl_next=(sl_next==(NSLOT-1)*SLOTB)?0:sl_next+SLOTB;}while(0)
  DMA_K(2,2*SLOTB);
  WAIT_BAR(3);
  qkt(pA0,pA1,Kbase,qr,negm,r32,hi);asm volatile("s_nop 15\n\ts_nop 7":"+v"(pA0),"+v"(pA1));CMASK(pA0,pA1,0);
  START(pA0,pA1);
  _Pragma("unroll") for(int r=0;r<16;++r)pA1[r]=__builtin_amdgcn_exp2f(pA1[r]);
  WAIT_BAR(0);
  DMA_K(3,0);DMA_V(1,SLOTB);
  ROT();
  kload8(kf,kp0+sl_cur);
  WAIT_BAR(2);
  s16x4 vlo[8],vhi[8]; u32x4 pw0,pw1,pw2,pw3;
  #define PKW(P,B) cvtpk_s(P[B],P[B+1])
  #define PAF(k) __builtin_bit_cast(bf16x8,pw##k)
  #define VFR(i) (bf16x8){vlo[i][0],vlo[i][1],vlo[i][2],vlo[i][3],vhi[i][0],vhi[i][1],vhi[i][2],vhi[i][3]}
  #define PIN(x) asm volatile("":"+v"(x))
  #define MX3(a,b,c) __builtin_fmaxf(__builtin_fmaxf((a),(b)),(c))
  #define GAPA(MF,A0,A1,A2,A3,W0,W1,PW) do{ MF; sacc+=A0; sacc+=A1; sacc+=A2; sacc+=A3; PIN(sacc); W0; W1; PIN(PW); SBAR(); }while(0)
  #define EX(v) __builtin_amdgcn_exp2f(v)
  #define GAPB(MF,X,B) do{ MF; X[B]=EX(X[B]); X[B+1]=EX(X[B+1]); X[B+2]=EX(X[B+2]); X[B+3]=EX(X[B+3]); PIN(X); SBAR(); }while(0)
  #define VRD(i) do{ vlo[i]=vtr(vp_+(((i)>>2)*4096+((i)&3)*1024)); vhi[i]=vtr(vp_+(((i)>>2)*4096+((i)&3)*1024+512)); }while(0)
  #define KRD(G,j) do{ if(G){ kload2(kf,kp0+sl_next,j); SBAR(); } }while(0)
  #define STEP(C0,C1,P0,P1,t,GK,GV,GL) do{ SBAR(); \
    const lds_cptr vp_=vp0+sl_prev; \
    VRD(0); SBAR(); float sacc=(P0[0]+P0[1]); \
    GAPA(C0=__builtin_amdgcn_mfma_f32_32x32x16_bf16(kf[0],qr[0],negm,0,0,0), P0[2],P0[3],P0[4],P0[5],     pw0[0]=PKW(P0,0), pw0[1]=PKW(P0,2), pw0); \
    VRD(4); SBAR(); GAPA(C1=__builtin_amdgcn_mfma_f32_32x32x16_bf16(kf[1],qr[0],negm,0,0,0), P0[6],P0[7],P0[8],P0[9],     pw0[2]=PKW(P0,4), pw0[3]=PKW(P0,6), pw0); \
    VRD(1); SBAR(); GAPA(C0=__builtin_amdgcn_mfma_f32_32x32x16_bf16(kf[2],qr[1],C0,0,0,0),   P0[10],P0[11],P0[12],P0[13], pw1[0]=PKW(P0,8), pw1[1]=PKW(P0,10), pw1); \
    VRD(5); SBAR(); GAPA(C1=__builtin_amdgcn_mfma_f32_32x32x16_bf16(kf[3],qr[1],C1,0,0,0),   P0[14],P0[15],P1[0],P1[1],   pw1[2]=PKW(P0,12),pw1[3]=PKW(P0,14), pw1); \
    VRD(2); SBAR(); GAPA(C0=__builtin_amdgcn_mfma_f32_32x32x16_bf16(kf[4],qr[2],C0,0,0,0),   P1[2],P1[3],P1[4],P1[5],     pw2[0]=PKW(P1,0), pw2[1]=PKW(P1,2), pw2); \
    VRD(6); SBAR(); GAPA(C1=__builtin_amdgcn_mfma_f32_32x32x16_bf16(kf[5],qr[2],C1,0,0,0),   P1[6],P1[7],P1[8],P1[9],     pw2[2]=PKW(P1,4), pw2[3]=PKW(P1,6), pw2); \
    VRD(3); SBAR(); GAPA(C0=__builtin_amdgcn_mfma_f32_32x32x16_bf16(kf[6],qr[3],C0,0,0,0),   P1[10],P1[11],P1[12],P1[13], pw3[0]=PKW(P1,8), pw3[1]=PKW(P1,10), pw3); \
    VRD(7); SBAR(); GAPA(C1=__builtin_amdgcn_mfma_f32_32x32x16_bf16(kf[7],qr[3],C1,0,0,0),   P1[14],P1[15],0.f,0.f,       pw3[2]=PKW(P1,12),pw3[3]=PKW(P1,14), pw3); \
    l_reg+=sacc; \
    if(GK){DMA_K((t)+3,sl_cur);} if(GV){DMA_V((t)+1,sl_next);} \
    CMASK(C0,C1,t); \
    { float a=MX3(C0[0],C0[1],C1[0]),b=MX3(C0[2],C0[3],C1[1]); a=MX3(a,C1[2],C1[3]); \
      _Pragma("unroll") for(int r=4;r<16;r+=4){a=MX3(a,C0[r],C0[r+1]);b=MX3(b,C0[r+2],C0[r+3]);a=MX3(a,C1[r],C1[r+1]);b=MX3(b,C1[r+2],C1[r+3]);} \
      float rm=__builtin_fmaxf(a,b); { auto rr=__builtin_amdgcn_permlane32_swap(__float_as_uint(rm),__float_as_uint(rm),false,false); rm=__builtin_fmaxf(__uint_as_float(rr[0]),__uint_as_float(rr[1])); } \
      resc=false; \
      if(__builtin_expect(__any(rm>(float)THRL),0)){ const float dl=__builtin_fmaxf(rm,0.f); mhat+=dl; \
        _Pragma("unroll") for(int r=0;r<16;++r){C0[r]-=dl;C1[r]-=dl;} \
        _Pragma("unroll") for(int r=0;r<16;++r)negm[r]=-mhat; asm volatile("":"+v"(negm)); \
        const float f=__builtin_amdgcn_exp2f(-dl); l_reg*=f; if(hi==0)wsf[r32]=f; resc=true; } } \
    SBAR(); \
    GAPB(o[0]=__builtin_amdgcn_mfma_f32_32x32x16_bf16(PAF(0),VFR(0),o[0],0,0,0), C0,0); \
    GAPB(o[1]=__builtin_amdgcn_mfma_f32_32x32x16_bf16(PAF(0),VFR(4),o[1],0,0,0), C0,4); \
    KRD(GL,0); GAPB(o[0]=__builtin_amdgcn_mfma_f32_32x32x16_bf16(PAF(1),VFR(1),o[0],0,0,0), C0,8); \
    KRD(GL,1); GAPB(o[1]=__builtin_amdgcn_mfma_f32_32x32x16_bf16(PAF(1),VFR(5),o[1],0,0,0), C0,12); \
    KRD(GL,2); GAPB(o[0]=__builtin_amdgcn_mfma_f32_32x32x16_bf16(PAF(2),VFR(2),o[0],0,0,0), C1,0); \
    KRD(GL,3); GAPB(o[1]=__builtin_amdgcn_mfma_f32_32x32x16_bf16(PAF(2),VFR(6),o[1],0,0,0), C1,4); \
    GAPB(o[0]=__builtin_amdgcn_mfma_f32_32x32x16_bf16(PAF(3),VFR(3),o[0],0,0,0), C1,8); \
    GAPB(o[1]=__builtin_amdgcn_mfma_f32_32x32x16_bf16(PAF(3),VFR(7),o[1],0,0,0), C1,12); \
    }while(0)
  int t=1;
  #undef CMASK
  #define CMASK(P0,P1,t) do{}while(0)
  for(;t+5<NT;t+=2){
    STEP(pB0,pB1,pA0,pA1,t,true,true,true);     WAIT_BAR(2); RESC(); ROT();
    STEP(pA0,pA1,pB0,pB1,t+1,true,true,true);   WAIT_BAR(2); RESC(); ROT();
  }
  #undef CMASK
  #define CMASK(P0,P1,t) do{int jb_=(t)-(NT-4); if(jb_>=0)cmask(P0,P1,jb_,qrel,hi);}while(0)
  #define ENDW(tt) do{ if((tt)+3<NT){WAIT_BAR(2);} else if((tt)+2<NT){WAIT_BAR(1);} else {WAIT_BAR(0);} }while(0)
  for(;t+1<NT;t+=2){
    STEP(pB0,pB1,pA0,pA1,t,(t+3<NT),(t+1<NT),(t+1<NT));       ENDW(t);   RESC(); ROT();
    STEP(pA0,pA1,pB0,pB1,t+1,(t+4<NT),(t+2<NT),(t+2<NT));     ENDW(t+1); RESC(); ROT();
  }
  STEP(pB0,pB1,pA0,pA1,NT-1,false,false,false); RESC();
  { float sacc=pB0[0]+pB0[1]; _Pragma("unroll") for(int r=2;r<16;++r)sacc+=pB0[r]; _Pragma("unroll") for(int r=0;r<16;++r)sacc+=pB1[r]; l_reg+=sacc;
    pw0=(u32x4){PKW(pB0,0),PKW(pB0,2),PKW(pB0,4),PKW(pB0,6)};pw1=(u32x4){PKW(pB0,8),PKW(pB0,10),PKW(pB0,12),PKW(pB0,14)};pw2=(u32x4){PKW(pB1,0),PKW(pB1,2),PKW(pB1,4),PKW(pB1,6)};pw3=(u32x4){PKW(pB1,8),PKW(pB1,10),PKW(pB1,12),PKW(pB1,14)};
    SBAR(); pv(o,vb0+sl_cur,PAF(0),PAF(1),PAF(2),PAF(3)); }
  #undef PKW
  #undef PAF
  #undef VFR
  #undef PIN
  #undef MX3
  #undef GAPA
  #undef GAPB
  #undef EX
  #undef VRD
  #undef KRD
  #undef STEP
  #undef ENDW
  {auto rr=__builtin_amdgcn_permlane32_swap(__float_as_uint(l_reg),__float_as_uint(l_reg),false,false);l_reg=__uint_as_float(rr[0])+__uint_as_float(rr[1]);}
  if(hi==0)wsf[32+r32]=l_reg;asm volatile("s_waitcnt lgkmcnt(0)":::"memory");
  float rli[16];
  #pragma unroll
  for(int r=0;r<16;++r)rli[r]=__builtin_amdgcn_rcpf(wsf[32+crow(r,hi)]);
  bf16*Ow=Ou+(long)(wid*QBLK)*OPITCH;
  { bf16*stg=(bf16*)(shm+LDS_OST)+wid*2048;
    #pragma unroll
    for(int r=0;r<16;++r){const int orow=crow(r,hi);
      #pragma unroll
      for(int d0=0;d0<2;++d0)stg[orow*64+d0*32+r32]=__float2bfloat16(o[d0][r]*rli[r]);}
    asm volatile("s_waitcnt lgkmcnt(0)":::"memory");
    #pragma unroll
    for(int i=0;i<4;++i){const int row=i*8+(lane>>3),ch=lane&7; const u32x4 v=*(const u32x4*)(stg+row*64+ch*8); ATTN_STORE16(Ow+(long)row*OPITCH+ch*8,v);} }
  asm volatile("s_waitcnt lgkmcnt(0)\n\ts_barrier":::"memory");
  #undef DMA_K
  #undef DMA_V
  #undef CMASK
  #undef START
  #undef RESC
  #undef ROT
}
constexpr int ATTN_LDS_BYTES=LDS_BYTES;
#undef SBAR
#undef WAIT_BAR
}


#ifndef EN_P0
#define EN_P0 1
#endif
#ifndef EN_SCAN
#define EN_SCAN 1
#endif
#ifndef EN_POST
#define EN_POST 1
#endif
#ifndef EN_ATTN
#define EN_ATTN 1
#endif
#ifndef EN_COMB
#define EN_COMB 1
#endif
#ifndef EN_GEMM
#define EN_GEMM 1
#endif
#ifndef EN_RP
#define EN_RP 1
#endif
#define GAS __attribute__((address_space(1)))
#define LAS __attribute__((address_space(3)))
typedef unsigned short bf16;
typedef unsigned v4u __attribute__((ext_vector_type(4)));
typedef unsigned v2u __attribute__((ext_vector_type(2)));
typedef float f32x4 __attribute__((ext_vector_type(4)));
namespace cg = cooperative_groups;

constexpr int NWAVES = 8;
constexpr int D = 1024, NP = 16384, NS = 1024, NTOK = NP + NS, NSEQ = 18, DFF = 2816, PAST = 2048;
constexpr int KS_ROWS = 2176, QS_ROWS = 256;
constexpr float LOG2E = 1.4426950408889634f;
constexpr float NORM_EPS = 1e-6f, GN_EPS = 64e-5f;
constexpr float LAM_INIT = 0.35550906759096934f;
constexpr size_t O_Y = 0, O_WKVP = 17825792, O_SHP = 17956864, O_KP = 17958912, O_VP = 34736128, O_WKVS = 51513344, O_SHS = 52561920, O_KS = 52578304, O_VS = 53626880, O_TOTAL = 54675456;
constexpr size_t MiB = 1u << 20;
constexpr size_t WS_MOD = 1 * MiB;
constexpr size_t MOD_KV_OFF = 2ull * 18 * 9216;
constexpr size_t WS_W = 4 * MiB;
constexpr size_t WE_IN = 0;
constexpr size_t WE_OUT = WE_IN + 4ull * 5632 * 1024;
constexpr size_t WE_RKV = WE_OUT + 4ull * 1024 * 2816;
constexpr size_t WE_L2 = WE_RKV + 3328ull * 2048;
constexpr size_t WE_WO = WE_L2 + 3072ull * 256;
constexpr size_t WE_KV = WE_WO + 1024ull * 1024;
constexpr size_t WE_Q = WE_KV + 2048ull * 1024;
constexpr size_t WE_DO = WE_Q + 1024ull * 1024;
constexpr size_t WE_END = WE_DO + 1024ull * 1024;
static_assert(WS_W + WE_END * 2 <= 96 * MiB, "weights region");
constexpr size_t WS_RAW = 96 * MiB;
constexpr size_t WS_A = 164 * MiB;
constexpr size_t WS_A2 = 232 * MiB;
constexpr size_t WS_T = 266 * MiB;
constexpr size_t WS_H = WS_T;
constexpr size_t WS_R = WS_T, WS_K = WS_T + 34 * MiB, WS_V = WS_T + 68 * MiB, WS_G = WS_T + 102 * MiB, WS_LORA = WS_T + 136 * MiB;
constexpr size_t WS_QP = WS_T, WS_QS = WS_T + 32 * MiB, WS_KP = WS_T + 40 * MiB, WS_VP = WS_T + 72 * MiB, WS_KSB = WS_T + 104 * MiB, WS_VSB = WS_T + 172 * MiB;
constexpr size_t WS_END = WS_T + 240 * MiB;
constexpr size_t WS_PART = WS_T + 96 * MiB;
constexpr int NPART = 11;
constexpr size_t WS_OP0 = WS_RAW, WS_OP1 = WS_A2, WS_OS = WS_A + 40 * MiB;
constexpr size_t WS_X16 = WS_RAW + 34 * MiB;
constexpr size_t WS_Y = WS_T + 138 * MiB;
static_assert(WS_H + (size_t)NTOK * DFF * 2 <= WS_END && WS_LORA + (size_t)NTOK * 256 * 2 <= WS_END, "overlay");

constexpr int LDS_BYTES = 147456;

__device__ __forceinline__ unsigned f2bf(float f) { unsigned u = __builtin_bit_cast(unsigned, f); return (u + 0x7fffu + ((u >> 16) & 1u)) >> 16; }
__device__ __forceinline__ unsigned pk2(float lo, float hi) { return f2bf(lo) | (f2bf(hi) << 16); }
__device__ __forceinline__ float bflo(unsigned w) { return __builtin_bit_cast(float, w << 16); }
__device__ __forceinline__ float bfhi(unsigned w) { return __builtin_bit_cast(float, w & 0xffff0000u); }
__device__ __forceinline__ float wave_sum(float v) {
#pragma unroll
    for (int o = 1; o < 64; o <<= 1) v += __shfl_xor(v, o);
    return v;
}
__device__ __forceinline__ float fsigmoid(float x) { return __builtin_amdgcn_rcpf(1.f + __builtin_amdgcn_exp2f(-x * LOG2E)); }
#define LDS_WAIT() asm volatile("s_waitcnt lgkmcnt(0)" ::: "memory")

struct Args { const float* in[37]; float* out; unsigned char* ws; int ph_lo, ph_hi; };

enum { EM_H = 0, EM_RAW, EM_R1, EM_R2, EM_KV, EM_Q, EM_ATOM };
constexpr double INVREV0 = 0.15915494309189535, INVREV1 = 0.03086376340470123, INVREV2 = 0.005985185712713705, INVREV3 = 0.001160663641240061,
                 INVREV4 = 0.00022507907903927653, INVREV5 = 4.364795279280289e-05, INVREV6 = 8.464330808241401e-06, INVREV7 = 1.6414262627950345e-06;
__device__ __forceinline__ void rope_cs(int pos, double ir, float& c, float& s) {
    double rv = (double)pos * ir; rv -= __builtin_floor(rv); const float f = (float)rv;
    c = __builtin_amdgcn_cosf(f); s = __builtin_amdgcn_sinf(f);
}
__device__ __forceinline__ void rope8(f32x4& v0, f32x4& v1, int pos, int fq) {
    f32x4 p0, p1;
#pragma unroll
    for (int i = 0; i < 4; ++i) { p0[i] = __shfl_xor(v0[i], 16); p1[i] = __shfl_xor(v1[i], 16); }
    if (fq < 2) {
        const float sg = (fq == 0) ? -1.f : 1.f; float c, s;
        rope_cs(pos, INVREV0, c, s); v0[0] = v0[0] * c + sg * p0[0] * s;
        rope_cs(pos, INVREV1, c, s); v0[1] = v0[1] * c + sg * p0[1] * s;
        rope_cs(pos, INVREV2, c, s); v0[2] = v0[2] * c + sg * p0[2] * s;
        rope_cs(pos, INVREV3, c, s); v0[3] = v0[3] * c + sg * p0[3] * s;
        rope_cs(pos, INVREV4, c, s); v1[0] = v1[0] * c + sg * p1[0] * s;
        rope_cs(pos, INVREV5, c, s); v1[1] = v1[1] * c + sg * p1[1] * s;
        rope_cs(pos, INVREV6, c, s); v1[2] = v1[2] * c + sg * p1[2] * s;
        rope_cs(pos, INVREV7, c, s); v1[3] = v1[3] * c + sg * p1[3] * s;
    }
}
__device__ __forceinline__ void st_bf16x8(bf16* p, const f32x4& v0, const f32x4& v1) {
    v4u w; w.x = pg8::cvt_pk_bf16(v0[0], v0[1]); w.y = pg8::cvt_pk_bf16(v0[2], v0[3]); w.z = pg8::cvt_pk_bf16(v1[0], v1[1]); w.w = pg8::cvt_pk_bf16(v1[2], v1[3]);
    *(v4u*)p = w;
}
template <int mode> struct EpiG {
    static constexpr bool PERM = true, AFTER_DRAIN = false;
    unsigned char* ws; float* f0;
    const float *c0, *c1;
    __device__ __forceinline__ void operator()(const pg8::f32x4 (&acc)[2][2][4][2], const pg8::Unit& u, int wr, int wc, int fr, int fq) const {
        const int rowb = u.pm * 256 + wr * 64 + fr;
        if constexpr (mode == EM_H) {
            const int col = u.pn * 128 + wc * 32 + 8 * fq;
#pragma unroll
            for (int ai = 0; ai < 2; ++ai)
#pragma unroll
                for (int m = 0; m < 4; ++m) {
                    const int row = rowb + ai * 128 + m * 16;
                    f32x4 h0, h1;
#pragma unroll
                    for (int i = 0; i < 4; ++i) { const float g0 = acc[ai][0][m][0][i], g1 = acc[ai][0][m][1][i];
                        h0[i] = g0 * fsigmoid(g0) * acc[ai][1][m][0][i]; h1[i] = g1 * fsigmoid(g1) * acc[ai][1][m][1][i]; }
                    st_bf16x8((bf16*)(ws + WS_H) + (size_t)row * DFF + col, h0, h1);
                }
        } else if constexpr (mode == EM_RAW) {
#pragma unroll
            for (int ai = 0; ai < 2; ++ai)
#pragma unroll
                for (int m = 0; m < 4; ++m) {
                    const int row = rowb + ai * 128 + m * 16;
#pragma unroll
                    for (int bj = 0; bj < 2; ++bj) st_bf16x8((bf16*)f0 + (size_t)row * D + u.pn * 256 + bj * 128 + wc * 32 + 8 * fq, acc[ai][bj][m][0], acc[ai][bj][m][1]);
                }
        } else if constexpr (mode == EM_ATOM) {
            bf16* base = (bf16*)f0 + (size_t)(u.kofs >> 8) * NS * D;
#pragma unroll
            for (int ai = 0; ai < 2; ++ai)
#pragma unroll
                for (int m = 0; m < 4; ++m) {
                    const int row = rowb + ai * 128 + m * 16;
#pragma unroll
                    for (int bj = 0; bj < 2; ++bj) st_bf16x8(base + (size_t)row * D + u.pn * 256 + bj * 128 + wc * 32 + 8 * fq, acc[ai][bj][m][0], acc[ai][bj][m][1]);
                }
        } else if constexpr (mode == EM_R1) {
            if (u.pn < 12) {
                const int t = u.pn >> 2; bf16* dst = (bf16*)(ws + WS_R + (size_t)t * (WS_K - WS_R));
#pragma unroll
                for (int ai = 0; ai < 2; ++ai)
#pragma unroll
                    for (int m = 0; m < 4; ++m) {
                        const int row = rowb + ai * 128 + m * 16;
#pragma unroll
                        for (int bj = 0; bj < 2; ++bj) st_bf16x8(dst + (size_t)row * D + (u.pn & 3) * 256 + bj * 128 + wc * 32 + 8 * fq, acc[ai][bj][m][0], acc[ai][bj][m][1]);
                    }
            } else {
#pragma unroll
                for (int ai = 0; ai < 2; ++ai)
#pragma unroll
                    for (int m = 0; m < 4; ++m) {
                        const int row = rowb + ai * 128 + m * 16;
#pragma unroll
                        for (int bj = 0; bj < 2; ++bj) {
                            f32x4 v0 = acc[ai][bj][m][0], v1 = acc[ai][bj][m][1];
                            if (bj == 1) {
#pragma unroll
                                for (int i = 0; i < 4; ++i) { v0[i] = fsigmoid(v0[i]); v1[i] = fsigmoid(v1[i]); }
                            } else if (wc < 2) {
#pragma unroll
                                for (int i = 0; i < 4; ++i) { v0[i] = 1.f - 2.f * __builtin_amdgcn_rcpf(__builtin_amdgcn_exp2f(2.f * LOG2E * v0[i]) + 1.f);
                                                              v1[i] = 1.f - 2.f * __builtin_amdgcn_rcpf(__builtin_amdgcn_exp2f(2.f * LOG2E * v1[i]) + 1.f); }
                            }
                            st_bf16x8((bf16*)(ws + WS_LORA) + (size_t)row * 256 + bj * 128 + wc * 32 + 8 * fq, v0, v1);
                        }
                    }
            }
        } else if constexpr (mode == EM_R2) {
            const int t = u.pn >> 2;
#pragma unroll
            for (int ai = 0; ai < 2; ++ai)
#pragma unroll
                for (int m = 0; m < 4; ++m) {
                    const int row = rowb + ai * 128 + m * 16;
#pragma unroll
                    for (int bj = 0; bj < 2; ++bj) {
                        const int col = (u.pn & 3) * 256 + bj * 128 + wc * 32 + 8 * fq;
                        f32x4 v0 = acc[ai][bj][m][0], v1 = acc[ai][bj][m][1];
                        if (t == 0) {
                            const f32x4 z0 = *(const f32x4*)(c0 + col), z1 = *(const f32x4*)(c0 + col + 4);
#pragma unroll
                            for (int i = 0; i < 4; ++i) { v0[i] = 0.6065306597126334f * LOG2E * fsigmoid(v0[i] + z0[i]);
                                                          v1[i] = 0.6065306597126334f * LOG2E * fsigmoid(v1[i] + z1[i]); }
                            st_bf16x8((bf16*)f0 + (size_t)row * D + col, v0, v1);
                        } else if (t == 1) {
                            const f32x4 z0 = *(const f32x4*)(c1 + col), z1 = *(const f32x4*)(c1 + col + 4);
#pragma unroll
                            for (int i = 0; i < 4; ++i) { v0[i] = fsigmoid(v0[i] + z0[i]); v1[i] = fsigmoid(v1[i] + z1[i]); }
                            st_bf16x8((bf16*)(ws + WS_A2) + (size_t)row * D + col, v0, v1);
                        } else st_bf16x8((bf16*)(ws + WS_G) + (size_t)row * D + col, v0, v1);
                    }
                }
        } else if constexpr (mode == EM_KV) {
            const bool isk = u.pn < 4; const bool dorope = isk && ((wc & 1) == 0);
#pragma unroll
            for (int ai = 0; ai < 2; ++ai)
#pragma unroll
                for (int m = 0; m < 4; ++m) {
                    const int row = rowb + ai * 128 + m * 16;
                    const bool smp = row >= NP; const int rs = row - NP;
                    const int pos = smp ? PAST + (rs & 63) : (row & 8191);
                    const size_t orow = smp ? (isk ? O_KS : O_VS) + (size_t)rs * D : (isk ? O_KP : O_VP) + (size_t)row * D;
                    const size_t boff = smp ? (isk ? WS_KSB : WS_VSB) + ((size_t)(rs >> 6) * KS_ROWS + PAST + (rs & 63)) * D * 2 : (isk ? WS_KP : WS_VP) + (size_t)row * D * 2;
                    bf16* brow = (bf16*)(ws + boff);
#pragma unroll
                    for (int bj = 0; bj < 2; ++bj) {
                        const int col = (u.pn & 3) * 256 + bj * 128 + wc * 32 + 8 * fq;
                        f32x4 v0 = acc[ai][bj][m][0], v1 = acc[ai][bj][m][1];
                        if (dorope) rope8(v0, v1, pos, fq);
                        float* p = f0 + orow + col; *(f32x4*)p = v0; *(f32x4*)(p + 4) = v1;
                        st_bf16x8(brow + col, v0, v1);
                    }
                }
        } else {
            const bool dorope = ((wc & 1) == 0);
#pragma unroll
            for (int ai = 0; ai < 2; ++ai)
#pragma unroll
                for (int m = 0; m < 4; ++m) {
                    const int row = rowb + ai * 128 + m * 16;
                    const bool smp = row >= NP; const int rs = row - NP;
                    const int pos = smp ? PAST + (rs & 63) : (row & 8191);
                    const size_t boff = smp ? WS_QS + ((size_t)(rs >> 6) * QS_ROWS + 128 + (rs & 63)) * D * 2 : WS_QP + (size_t)row * D * 2;
                    bf16* brow = (bf16*)(ws + boff);
#pragma unroll
                    for (int bj = 0; bj < 2; ++bj) {
                        const int col = u.pn * 256 + bj * 128 + wc * 32 + 8 * fq;
                        f32x4 v0 = acc[ai][bj][m][0], v1 = acc[ai][bj][m][1];
                        if (dorope) rope8(v0, v1, pos, fq);
                        v0 = v0 * attn_body::C2; v1 = v1 * attn_body::C2;
                        st_bf16x8(brow + col, v0, v1);
                    }
                }
        }
    }
};

__device__ __forceinline__ void tr_item(const float* W, int ldw, int k0, int n0, bf16* WT, int ldt, int drow0, int kdst0, const float* mu, int mumode, LAS float* scr, int lane) {
#pragma unroll
    for (int i = 0; i < 32; ++i) { const int kk = 2 * i + (lane >> 5); float v = W[(size_t)(k0 + kk) * ldw + n0 + (lane & 31)];
        if (mumode) { const float mv = mu[k0 + kk]; v *= (mumode == 1) ? mv : 1.f - mv; }
        scr[kk * 33 + (lane & 31)] = v; }
    LDS_WAIT(); asm volatile("" ::: "memory");
    const int c = lane & 7;
#pragma unroll
    for (int j = 0; j < 4; ++j) { const int n = (lane >> 3) + 8 * j; const LAS float* s = scr + (8 * c) * 33 + n;
        v4u o; o.x = pk2(s[0 * 33], s[1 * 33]); o.y = pk2(s[2 * 33], s[3 * 33]); o.z = pk2(s[4 * 33], s[5 * 33]); o.w = pk2(s[6 * 33], s[7 * 33]);
        *(v4u*)(WT + (size_t)(drow0 + n) * ldt + kdst0 + 8 * c) = o; }
    LDS_WAIT(); asm volatile("" ::: "memory");
}
__device__ __forceinline__ void zero_item(bf16* WT, int ldt, int drow0, int kdst0, int lane) {
    const int c = lane & 7;
#pragma unroll
    for (int j = 0; j < 4; ++j) { const int n = (lane >> 3) + 8 * j; *(v4u*)(WT + (size_t)(drow0 + n) * ldt + kdst0 + 8 * c) = (v4u){0u, 0u, 0u, 0u}; }
}
__device__ __forceinline__ void tr_job(const float* W, int N, bf16* WT, int ldt, int drow0, int kdst0, const float* mu, int mumode, int item, LAS float* scr, int lane) {
    const int nblk = N / 32, kb = item / nblk, nb = item % nblk;
    tr_item(W, N, 64 * kb, 32 * nb, WT, ldt, drow0 + 32 * nb, kdst0 + 64 * kb, mu, mumode, scr, lane);
}
__device__ __forceinline__ void p0_phase(const Args& a, LAS unsigned char* lds, int tid, int wave, int lane, int vcu, int G) {
    unsigned char* ws = a.ws;
    bf16* WB = (bf16*)(ws + WS_W);
    LAS float* scr = (LAS float*)(lds + wave * 16384);
    const int gw = vcu * NWAVES + wave, NGW = G * NWAVES;
    constexpr int I_IN = 16 * 176, I_OUT = 44 * 32, I_SQ = 16 * 32, I_L64 = 16 * 2, I_L128 = 16 * 4, I_L2 = 384, I_KV = 16 * 64;
    constexpr int C0 = 4 * I_IN, C1 = C0 + 4 * I_OUT, C2 = C1 + 6 * I_SQ, C3 = C2 + 4 * I_L64, C4 = C3 + 2 * I_L128, C5 = C4 + I_L2, C6 = C5 + I_SQ, C7 = C6 + I_KV, C8 = C7 + I_SQ, C9 = C8 + I_SQ;
    const float* mu = a.in[13];
    for (int it = gw; it < C9; it += NGW) {
        if (it < C0) { const int f = it / I_IN, r = it % I_IN; const int kb = r / 176, nb = r % 176;
            const int n0 = 32 * nb, half = n0 / DFF, j = n0 % DFF; const int drow = (j / 128) * 256 + half * 128 + (j % 128);
            tr_item(a.in[11] + (size_t)f * 1024 * 5632, 5632, 64 * kb, n0, WB + WE_IN + (size_t)f * 5632 * 1024, 1024, drow, 64 * kb, nullptr, 0, scr, lane);
        } else if (it < C1) { const int r0 = it - C0, f = r0 / I_OUT, r = r0 % I_OUT;
            tr_job(a.in[12] + (size_t)f * DFF * 1024, 1024, WB + WE_OUT + (size_t)f * 1024 * DFF, DFF, 0, 0, nullptr, 0, r, scr, lane);
        } else if (it < C2) { const int r0 = it - C1, jp = r0 / I_SQ, r = r0 % I_SQ; const int j = jp >> 1, part = jp & 1;
            const int mi = (j == 0) ? 0 : (j == 1) ? 2 : 3;
            tr_job(a.in[14] + (size_t)j * 1024 * 1024, 1024, WB + WE_RKV, 2048, j * 1024, part ? 1024 : 0, mu + mi * 1024, part ? 2 : 1, r, scr, lane);
        } else if (it < C3) { const int r0 = it - C2, jp = r0 / I_L64, r = r0 % I_L64; const int j = jp >> 1, part = jp & 1;
            tr_job(j == 0 ? a.in[16] : a.in[19], 64, WB + WE_RKV, 2048, 3072 + 64 * j, part ? 1024 : 0, mu + (j == 0 ? 1 : 4) * 1024, part ? 2 : 1, r, scr, lane);
        } else if (it < C4) { const int r0 = it - C3, part = r0 / I_L128, r = r0 % I_L128;
            tr_job(a.in[21], 128, WB + WE_RKV, 2048, 3200, part ? 1024 : 0, mu + 5 * 1024, part ? 2 : 1, r, scr, lane);
        } else if (it < C5) { const int r0 = it - C4, rb = r0 / 128, rem = r0 % 128, kc = rem / 32, nb = rem % 32;
            bf16* WT = WB + WE_L2; const int drow = rb * 1024 + 32 * nb;
            if (rb == 0 && kc == 0) tr_item(a.in[17], 1024, 0, 32 * nb, WT, 256, drow, 0, nullptr, 0, scr, lane);
            else if (rb == 1 && kc == 1) tr_item(a.in[20], 1024, 0, 32 * nb, WT, 256, drow, 64, nullptr, 0, scr, lane);
            else if (rb == 2 && kc >= 2) tr_item(a.in[22], 1024, (kc - 2) * 64, 32 * nb, WT, 256, drow, kc * 64, nullptr, 0, scr, lane);
            else zero_item(WT, 256, drow, kc * 64, lane);
        } else if (it < C6) { tr_job(a.in[28], 1024, WB + WE_WO, 1024, 0, 0, nullptr, 0, it - C5, scr, lane);
        } else if (it < C7) { tr_job(a.in[32], 2048, WB + WE_KV, 1024, 0, 0, nullptr, 0, it - C6, scr, lane);
        } else if (it < C8) { tr_job(a.in[33], 1024, WB + WE_Q, 1024, 0, 0, nullptr, 0, it - C7, scr, lane);
        } else { tr_job(a.in[36], 1024, WB + WE_DO, 1024, 0, 0, nullptr, 0, it - C8, scr, lane); }
    }
    __syncthreads();
    LAS float* sc = (LAS float*)lds;
    LAS float* red = (LAS float*)(lds + 73728);
    for (int i = tid; i < NSEQ * 1024; i += 512) { const int s = i >> 10, k = i & 1023; const float c = (s < 2) ? a.in[2][s * 1024 + k] : a.in[3][(s - 2) * 1024 + k]; sc[i] = c * fsigmoid(c); }
    __syncthreads();
    float* MOD = (float*)(ws + WS_MOD);
    for (int item = vcu; item < 320; item += G) {
        const float* W; const float* bias; float* dst; int N, col0, dstride;
        if (item < 288) { const int l = item / 144, cg_ = item % 144; N = 9216; col0 = cg_ * 64; W = a.in[8] + (size_t)l * 1024 * 9216; bias = a.in[9] + l * 9216; dst = MOD + (size_t)l * 18 * 9216; dstride = 9216; }
        else { N = 2048; col0 = (item - 288) * 64; W = a.in[29]; bias = a.in[30]; dst = MOD + MOD_KV_OFF; dstride = 2048; }
        float acc[NSEQ];
#pragma unroll
        for (int s = 0; s < NSEQ; ++s) acc[s] = 0.f;
        const float* wp = W + (size_t)(wave * 128) * N + col0 + lane;
        for (int k = 0; k < 128; k += 4) {
            const float w0 = wp[(size_t)(k + 0) * N], w1 = wp[(size_t)(k + 1) * N], w2 = wp[(size_t)(k + 2) * N], w3 = wp[(size_t)(k + 3) * N];
#pragma unroll
            for (int s = 0; s < NSEQ; ++s) { const f32x4 c4 = *(const LAS f32x4*)(sc + s * 1024 + wave * 128 + k); acc[s] += c4[0] * w0 + c4[1] * w1 + c4[2] * w2 + c4[3] * w3; }
        }
#pragma unroll
        for (int s = 0; s < NSEQ; ++s) red[(wave * NSEQ + s) * 64 + lane] = acc[s];
        __syncthreads();
        for (int o = tid; o < NSEQ * 64; o += 512) { const int s = o >> 6, l = o & 63; float v = bias[col0 + l];
#pragma unroll
            for (int w = 0; w < 8; ++w) v += red[(w * NSEQ + s) * 64 + l];
            dst[(size_t)s * dstride + col0 + l] = v; }
        __syncthreads();
    }
}

__device__ __forceinline__ void ld_row(f32x4 (&v)[4], const float* p, int lane) {
#pragma unroll
    for (int j = 0; j < 4; ++j) v[j] = *(const f32x4*)(p + 4 * lane + 256 * j);
}
__device__ __forceinline__ void ld_row_nt(f32x4 (&v)[4], const float* p, int lane) {
#pragma unroll
    for (int j = 0; j < 4; ++j) v[j] = __builtin_nontemporal_load((const f32x4*)(p + 4 * lane + 256 * j));
}
__device__ __forceinline__ float sumsq(const f32x4 (&v)[4]) { float s = 0.f;
#pragma unroll
    for (int j = 0; j < 4; ++j) s += (v[j][0] * v[j][0] + v[j][1] * v[j][1]) + (v[j][2] * v[j][2] + v[j][3] * v[j][3]);
    return wave_sum(s); }
template <int mode> __device__ __forceinline__ void rowpass(const Args& a, int gw, int NGW, int lane) {
    if (!EN_RP) return;
    unsigned char* ws = a.ws; float* XO = a.out + O_Y; bf16* X = (bf16*)(ws + WS_X16); const float* RAW = (const float*)(ws + WS_RAW);
    const float* MOD = (const float*)(ws + WS_MOD); const float* KVMOD = MOD + MOD_KV_OFF; const float* NG = a.in[10];
    bf16* A = (bf16*)(ws + WS_A); bf16* A2 = (bf16*)(ws + WS_A2);
    int lpost = 0, gchunk = 0, ngpost = 0; float gs = 0.f; bool has_raw = mode != 0;
    int lpre = 0, ngpre = 0, schunk = 0; bool has_a = mode != 6;
    switch (mode) {
        case 0: lpre = 0; ngpre = 0; schunk = 0; break;
        case 1: lpost = 0; gchunk = 2; ngpost = 1; gs = 0.5f; lpre = 0; ngpre = 2; schunk = 3; break;
        case 2: lpost = 0; gchunk = 5; ngpost = 3; gs = 1.0f; lpre = 0; ngpre = 4; schunk = 6; break;
        case 3: lpost = 0; gchunk = 8; ngpost = 5; gs = 0.5f; lpre = 1; ngpre = 0; schunk = 0; break;
        case 4: lpost = 1; gchunk = 2; ngpost = 1; gs = 0.5f; lpre = 1; ngpre = 2; schunk = 3; break;
        case 5: lpost = 1; gchunk = 5; ngpost = 3; gs = 1.0f; lpre = 1; ngpre = 4; schunk = 6; break;
        default: lpost = 1; gchunk = 8; ngpost = 5; gs = 0.5f; break;
    }
    const float* gate = MOD + (size_t)lpost * 18 * 9216 + gchunk * 1024;
    const float* ngp = NG + (lpost * 6 + ngpost) * 1024;
    const float* ng1 = NG + (lpre * 6 + ngpre) * 1024;
    const float* sh1 = MOD + (size_t)lpre * 18 * 9216 + schunk * 1024; const float* sc1 = sh1 + 1024;
#define RP_LOAD(row, x, r) do { const bool smp_ = (row) >= NP; const int rs_ = (row) - NP; \
        if (mode == 0 || mode == 1) ld_row_nt(x, smp_ ? a.in[1] + (size_t)rs_ * D : a.in[0] + (size_t)(row) * D, lane); else { _Pragma("unroll") for (int j = 0; j < 4; ++j) { const v2u w_ = __builtin_nontemporal_load((const v2u*)(X + (size_t)(row) * D + 4 * lane + 256 * j)); x[j] = (f32x4){bflo(w_.x), bfhi(w_.x), bflo(w_.y), bfhi(w_.y)}; } } \
        if (has_raw) { if (smp_) { constexpr int np_ = (mode == 2 || mode == 5) ? 4 : NPART; const bf16* pp_ = (const bf16*)(ws + WS_PART) + (size_t)rs_ * D + 4 * lane; _Pragma("unroll") for (int j = 0; j < 4; ++j) r[j] = (f32x4){0.f, 0.f, 0.f, 0.f}; \
                for (int p_ = 0; p_ < np_; ++p_) { _Pragma("unroll") for (int j = 0; j < 4; ++j) { const v2u w_ = *(const v2u*)(pp_ + (size_t)p_ * NS * D + 256 * j); r[j] = r[j] + (f32x4){bflo(w_.x), bfhi(w_.x), bflo(w_.y), bfhi(w_.y)}; } } } \
            else { _Pragma("unroll") for (int j = 0; j < 4; ++j) { const v2u w_ = __builtin_nontemporal_load((const v2u*)((const bf16*)RAW + (size_t)(row) * D + 4 * lane + 256 * j)); r[j] = (f32x4){bflo(w_.x), bfhi(w_.x), bflo(w_.y), bfhi(w_.y)}; } } } } while (0)
    for (int row0 = gw; row0 < NTOK; row0 += 2 * NGW) {
        const int row1 = row0 + NGW; const bool has1 = row1 < NTOK;
        f32x4 xx[2][4], rr[2][4];
        RP_LOAD(row0, xx[0], rr[0]);
        if (has1) RP_LOAD(row1, xx[1], rr[1]);
#pragma unroll
      for (int e = 0; e < 2; ++e) {
        if (e == 1 && !has1) break;
        const int row = e ? row1 : row0;
        f32x4 (&x)[4] = xx[e]; f32x4 (&r)[4] = rr[e];
        const bool smp = row >= NP; const int rs = row - NP;
        const int s = smp ? 2 + (rs >> 6) : (row >> 13);
        if (has_raw) {
            f32x4 g[4], n[4]; ld_row(g, gate + (size_t)s * 9216, lane); ld_row(n, ngp, lane);
            const float rstd = 1.f / sqrtf(sumsq(r) * (1.f / D) + NORM_EPS) * gs;
#pragma unroll
            for (int j = 0; j < 4; ++j) x[j] = x[j] + g[j] * r[j] * n[j] * rstd;
#pragma unroll
            for (int j = 0; j < 4; ++j) { if (mode == 6) __builtin_nontemporal_store(x[j], (f32x4*)(XO + (size_t)row * D + 4 * lane + 256 * j));
                else __builtin_nontemporal_store((v2u){pk2(x[j][0], x[j][1]), pk2(x[j][2], x[j][3])}, (v2u*)(X + (size_t)row * D + 4 * lane + 256 * j)); }
        }
        if (has_a) {
            const float rstd = 1.f / sqrtf(sumsq(x) * (1.f / D) + NORM_EPS);
            f32x4 n[4], sh[4], sc[4]; ld_row(n, ng1, lane); ld_row(sh, sh1 + (size_t)s * 9216, lane); ld_row(sc, sc1 + (size_t)s * 9216, lane);
            f32x4 y[4];
#pragma unroll
            for (int j = 0; j < 4; ++j) y[j] = x[j] * n[j] * rstd * (sc[j] + 1.f) + sh[j];
            if (mode != 1) {
#pragma unroll
                for (int j = 0; j < 4; ++j) *(v2u*)(A + (size_t)row * D + 4 * lane + 256 * j) = (v2u){pk2(y[j][0], y[j][1]), pk2(y[j][2], y[j][3])};
            } else {
                const int t = smp ? (rs & 63) : (row & 8191); const int len = smp ? 64 : 8192;
#pragma unroll
                for (int j = 0; j < 4; ++j) { const v2u w = (v2u){pk2(y[j][0], y[j][1]), pk2(y[j][2], y[j][3])};
                    *(v2u*)(A + (size_t)row * 2048 + 1024 + 4 * lane + 256 * j) = w;
                    if (t + 1 < len) *(v2u*)(A + (size_t)(row + 1) * 2048 + 4 * lane + 256 * j) = w; }
                if (t == 0) {
#pragma unroll
                    for (int j = 0; j < 4; ++j) { v2u w = (v2u){0u, 0u};
                        if (smp) { const f32x4 sv = *(const f32x4*)(a.in[5] + (size_t)(rs >> 6) * D + 4 * lane + 256 * j); w = (v2u){pk2(sv[0], sv[1]), pk2(sv[2], sv[3])}; }
                        *(v2u*)(A + (size_t)row * 2048 + 4 * lane + 256 * j) = w; }
                }
                if (t == len - 1) { float* so = a.out + (smp ? O_SHS + (size_t)(rs >> 6) * D : O_SHP + (size_t)(row >> 13) * D);
#pragma unroll
                    for (int j = 0; j < 4; ++j) *(f32x4*)(so + 4 * lane + 256 * j) = y[j]; }
            }
        }
        if (mode == 3) {
            const float rstd = 1.f / sqrtf(sumsq(x) * (1.f / D) + NORM_EPS);
            f32x4 n[4], sh[4], sc[4]; ld_row(n, a.in[31], lane); ld_row(sh, KVMOD + (size_t)s * 2048, lane); ld_row(sc, KVMOD + (size_t)s * 2048 + 1024, lane);
#pragma unroll
            for (int j = 0; j < 4; ++j) { const f32x4 y = x[j] * n[j] * rstd * (sc[j] + 1.f) + sh[j];
                *(v2u*)(A2 + (size_t)row * D + 4 * lane + 256 * j) = (v2u){pk2(y[0], y[1]), pk2(y[2], y[3])}; }
        }
      }
    }
#undef RP_LOAD
}

template <int N> __device__ __forceinline__ float ror16(float x) { return __builtin_bit_cast(float, __builtin_amdgcn_update_dpp(0, __builtin_bit_cast(int, x), 0x120 + N, 0xF, 0xF, false)); }
__device__ __forceinline__ float red16(float x) { x += ror16<8>(x); x += ror16<4>(x); x += ror16<2>(x); x += ror16<1>(x); return x; }
constexpr int SC_STEPS = 32, SC_STEPB = 1536, SC_CCOFF = SC_STEPS * SC_STEPB, SC_BUFB = SC_CCOFF + 128, SC_YOFF = 2 * SC_BUFB;
static_assert(SC_YOFF + 2 * 16384 <= 131072 + 320, "scan LDS map");
struct PrepRegs { v2u k[2], a[2], r[2], v[2], w[2]; };
__device__ __forceinline__ void prep_load(PrepRegs& P, const bf16* Rb, const bf16* Kb, const bf16* Vb, const bf16* Ab, const bf16* Wb, size_t off0) {
#pragma unroll
    for (int p = 0; p < 2; ++p) { const size_t off = off0 + (size_t)p * D;
        P.k[p] = *(const v2u*)(Kb + off); P.a[p] = *(const v2u*)(Ab + off); P.r[p] = *(const v2u*)(Rb + off); P.v[p] = *(const v2u*)(Vb + off); P.w[p] = *(const v2u*)(Wb + off); }
}
__device__ __forceinline__ void prep_compute(const PrepRegs& P, LAS unsigned char* buf, int st, int cg4, const f32x4& kkc, const f32x4& kac) {
    f32x4 kk[2], bb[2], kp[2], w0 = (f32x4){0.f, 0.f, 0.f, 0.f};
#pragma unroll
    for (int p = 0; p < 2; ++p) {
        const f32x4 k = (f32x4){bflo(P.k[p].x), bfhi(P.k[p].x), bflo(P.k[p].y), bfhi(P.k[p].y)};
        const f32x4 av = (f32x4){bflo(P.a[p].x), bfhi(P.a[p].x), bflo(P.a[p].y), bfhi(P.a[p].y)};
        const f32x4 r = (f32x4){bflo(P.r[p].x), bfhi(P.r[p].x), bflo(P.r[p].y), bfhi(P.r[p].y)};
        const f32x4 v = (f32x4){bflo(P.v[p].x), bfhi(P.v[p].x), bflo(P.v[p].y), bfhi(P.v[p].y)};
        if (p == 0) w0 = (f32x4){__builtin_amdgcn_exp2f(-bflo(P.w[0].x)), __builtin_amdgcn_exp2f(-bfhi(P.w[0].x)), __builtin_amdgcn_exp2f(-bflo(P.w[0].y)), __builtin_amdgcn_exp2f(-bfhi(P.w[0].y))};
        const f32x4 wd = (p == 0) ? w0 : (f32x4){__builtin_amdgcn_exp2f(-bflo(P.w[1].x)), __builtin_amdgcn_exp2f(-bfhi(P.w[1].x)), __builtin_amdgcn_exp2f(-bflo(P.w[1].y)), __builtin_amdgcn_exp2f(-bfhi(P.w[1].y))};
        const f32x4 uu = k * kkc;
        const float n2 = red16((uu[0] * uu[0] + uu[1] * uu[1]) + (uu[2] * uu[2] + uu[3] * uu[3]));
        const float inv = 1.f / fmaxf(sqrtf(n2), 1e-12f);
        kk[p] = uu * inv; bb[p] = kk[p] * av; kp[p] = k * ((av - 1.f) * kac + 1.f);
        LAS unsigned char* b = buf + (2 * st + p) * SC_STEPB + cg4 * 16;
        *(LAS f32x4*)(b) = wd; *(LAS f32x4*)(b + 256) = kp[p]; *(LAS f32x4*)(b + 768) = bb[p]; *(LAS f32x4*)(b + 1024) = r; *(LAS f32x4*)(b + 1280) = v;
        if (p == 0) *(LAS f32x4*)(b + 512) = kk[0];
        else *(LAS f32x4*)(b + 512) = w0 * kk[1];
    }
    const f32x4 t1 = bb[0] * kk[1], t2 = kp[0] * kk[1];
    const float c1 = red16((t1[0] + t1[1]) + (t1[2] + t1[3])), c2 = red16((t2[0] + t2[1]) + (t2[2] + t2[3]));
    if (cg4 == 0) { typedef float f32x2 __attribute__((ext_vector_type(2))); *(LAS f32x2*)(buf + SC_CCOFF + st * 8) = (f32x2){c1, c2}; }
}
__device__ __forceinline__ void scan_item(const Args& a, LAS unsigned char* lds, int wave, int lane, int tok0, int nsteps, int h, int rg, const float* s0, float* sT, bool reuse) {
    unsigned char* ws = a.ws;
    const bf16* Rb = (const bf16*)(ws + WS_R); const bf16* Kb = (const bf16*)(ws + WS_K); const bf16* Vb = (const bf16*)(ws + WS_V); const bf16* Ab = (const bf16*)(ws + WS_A2);
    const bf16* Wb = (const bf16*)(ws + WS_A); bf16* Y = (bf16*)(ws + WS_Y);
    const int nch = nsteps / SC_STEPS;
    const bool is_scan = wave < 2, is_prep = (wave >= 2 && wave < 6) && !reuse;
    const int plane = (wave - 2) * 64 + lane, st = plane >> 4, cg4 = plane & 15;
    const size_t poff = (size_t)(tok0 + 2 * st) * D + h * 64 + cg4 * 4;
    f32x4 kkc = (f32x4){0.f, 0.f, 0.f, 0.f}, kac = kkc; PrepRegs P, P2;
    const int row4 = lane >> 4, kq = lane & 15, vrow = rg * 8 + (wave & 1) * 4 + row4;
    f32x4 S = (f32x4){0.f, 0.f, 0.f, 0.f};
    if (is_scan && s0) S = *(const f32x4*)(s0 + (size_t)vrow * 64 + kq * 4);
    if (is_prep) { kkc = *(const f32x4*)(a.in[23] + h * 64 + cg4 * 4); kac = *(const f32x4*)(a.in[24] + h * 64 + cg4 * 4);
        prep_load(P2, Rb, Kb, Vb, Ab, Wb, poff); prep_compute(P2, lds, st, cg4, kkc, kac);
        if (nch > 1) prep_load(P, Rb, Kb, Vb, Ab, Wb, poff + (size_t)SC_STEPS * D);
        if (nch > 2) prep_load(P2, Rb, Kb, Vb, Ab, Wb, poff + (size_t)2 * SC_STEPS * D); }
    __syncthreads();
    typedef float f32x2 __attribute__((ext_vector_type(2)));
    f32x2 Sa = (f32x2){S[0], S[1]}, Sb = (f32x2){S[2], S[3]};
    if (is_scan) __builtin_amdgcn_s_setprio(3);
    for (int c = 0; c < nch; ++c) {
        LAS unsigned char* buf = lds + (c & 1) * SC_BUFB;
        if (is_scan) {
            LAS float* yp = (LAS float*)(lds + SC_YOFF + (c & 1) * 16384) + (wave & 1) * 64 + lane;
            const LAS unsigned char* bp = buf + kq * 16; const LAS unsigned char* vp = buf + 1280 + vrow * 4;
            f32x4 Wv[3][2], KPv[3][2], KKv[3][2], BBv[3][2], Rv[3][2]; float Vv[3][2]; f32x2 CC[3];
#define SLOAD(slot, pr_) do { _Pragma("unroll") for (int e_ = 0; e_ < 2; ++e_) { const LAS unsigned char* q_ = bp + (2 * (pr_) + e_) * SC_STEPB; \
        Wv[slot][e_] = *(const LAS f32x4*)(q_); KPv[slot][e_] = *(const LAS f32x4*)(q_ + 256); KKv[slot][e_] = *(const LAS f32x4*)(q_ + 512); \
        BBv[slot][e_] = *(const LAS f32x4*)(q_ + 768); Rv[slot][e_] = *(const LAS f32x4*)(q_ + 1024); Vv[slot][e_] = *(const LAS float*)(vp + (2 * (pr_) + e_) * SC_STEPB); } \
        CC[slot] = *(const LAS f32x2*)(buf + SC_CCOFF + (pr_) * 8); } while (0)
#define LO2(x) ((f32x2){(x)[0], (x)[1]})
#define HI2(x) ((f32x2){(x)[2], (x)[3]})
            SLOAD(0, 0); SLOAD(1, 1);
#pragma unroll
            for (int pr = 0; pr < SC_STEPS / 2; ++pr) {
                if (pr + 2 < SC_STEPS / 2) SLOAD((pr + 2) % 3, pr + 2);
                const int q = pr % 3;
                const f32x2 e0 = Sa * LO2(KKv[q][0]) + Sb * HI2(KKv[q][0]);
                const f32x2 e1 = Sa * LO2(KKv[q][1]) + Sb * HI2(KKv[q][1]);
                const float v0 = Vv[q][0], v1 = Vv[q][1];
                const f32x2 Ta = Sa * LO2(Wv[q][0]) + LO2(KPv[q][0]) * v0, Tb = Sb * HI2(Wv[q][0]) + HI2(KPv[q][0]) * v0;
                const float sa0 = red16(e0[0] + e0[1]);
                const float d1 = red16(e1[0] + e1[1]) + v0 * CC[q][1];
                const float sa1 = d1 - sa0 * CC[q][0];
                Sa = Ta - LO2(BBv[q][0]) * sa0; Sb = Tb - HI2(BBv[q][0]) * sa0;
                const f32x2 y0 = Sa * LO2(Rv[q][0]) + Sb * HI2(Rv[q][0]);
                yp[(2 * pr) * 128] = y0[0] + y0[1];
                Sa = (Sa * LO2(Wv[q][1]) + LO2(KPv[q][1]) * v1) - LO2(BBv[q][1]) * sa1;
                Sb = (Sb * HI2(Wv[q][1]) + HI2(KPv[q][1]) * v1) - HI2(BBv[q][1]) * sa1;
                const f32x2 y1 = Sa * LO2(Rv[q][1]) + Sb * HI2(Rv[q][1]);
                yp[(2 * pr + 1) * 128] = y1[0] + y1[1];
            }
#undef LO2
#undef HI2
#undef SLOAD
        } else if (is_prep) {
            if (c + 1 < nch) { prep_compute(P, lds + ((c + 1) & 1) * SC_BUFB, st, cg4, kkc, kac);
                if (c + 3 < nch) prep_load(P, Rb, Kb, Vb, Ab, Wb, poff + (size_t)(c + 3) * SC_STEPS * D);
                const PrepRegs T_ = P; P = P2; P2 = T_; }
        } else if (wave >= 6 && c > 0) {
            const LAS float* ypb = (const LAS float*)(lds + SC_YOFF + ((c - 1) & 1) * 16384);
#pragma unroll
            for (int i = 0; i < 2; ++i) { const int o = lane + 64 * i, stp = (wave - 6) * 16 + (o >> 3), r8 = o & 7;
                const LAS f32x4* pp = (const LAS f32x4*)(ypb + (stp * 2 + (r8 >> 2)) * 64 + (r8 & 3) * 16);
                const f32x4 p0 = pp[0], p1 = pp[1], p2 = pp[2], p3 = pp[3];
                const f32x4 t = (p0 + p1) + (p2 + p3);
                Y[(size_t)(tok0 + (c - 1) * SC_STEPS + stp) * D + h * 64 + rg * 8 + r8] = (bf16)f2bf((t[0] + t[1]) + (t[2] + t[3])); }
        }
        __syncthreads();
    }
    if (is_scan) __builtin_amdgcn_s_setprio(0);
    if (wave >= 6) {
        const LAS float* ypb = (const LAS float*)(lds + SC_YOFF + ((nch - 1) & 1) * 16384);
#pragma unroll
        for (int i = 0; i < 2; ++i) { const int o = lane + 64 * i, stp = (wave - 6) * 16 + (o >> 3), r8 = o & 7;
            const LAS f32x4* pp = (const LAS f32x4*)(ypb + (stp * 2 + (r8 >> 2)) * 64 + (r8 & 3) * 16);
            const f32x4 p0 = pp[0], p1 = pp[1], p2 = pp[2], p3 = pp[3];
            const f32x4 t = (p0 + p1) + (p2 + p3);
            Y[(size_t)(tok0 + (nch - 1) * SC_STEPS + stp) * D + h * 64 + rg * 8 + r8] = (bf16)f2bf((t[0] + t[1]) + (t[2] + t[3])); }
    }
    if (is_scan) *(f32x4*)(sT + (size_t)vrow * 64 + kq * 4) = (f32x4){Sa[0], Sa[1], Sb[0], Sb[1]};
    __syncthreads();
}
__device__ __forceinline__ void scan_phase(const Args& a, LAS unsigned char* lds, int wave, int lane, int vcu, int G) {
    for (int it = vcu; it < 256 + 2048; it += G) {
        if (it < 256) { const int bh = it >> 3, rg = it & 7, b = bh >> 4, h = bh & 15;
            scan_item(a, lds, wave, lane, b * 8192, 8192, h, rg, nullptr, a.out + O_WKVP + (size_t)bh * 4096, false);
        } else { const int j = it - 256; const int rg = j >> 8, bh = j & 255, b = bh >> 4, h = bh & 15;
            scan_item(a, lds, wave, lane, NP + b * 64, 64, h, rg, a.in[4] + (size_t)bh * 4096, a.out + O_WKVS + (size_t)bh * 4096, (G == 256) && rg > 0); }
    }
}
__device__ __forceinline__ void ld16bf(float (&o)[16], const bf16* p) {
    const v4u w0 = *(const v4u*)p, w1 = *(const v4u*)(p + 8);
    o[0] = bflo(w0.x); o[1] = bfhi(w0.x); o[2] = bflo(w0.y); o[3] = bfhi(w0.y); o[4] = bflo(w0.z); o[5] = bfhi(w0.z); o[6] = bflo(w0.w); o[7] = bfhi(w0.w);
    o[8] = bflo(w1.x); o[9] = bfhi(w1.x); o[10] = bflo(w1.y); o[11] = bfhi(w1.y); o[12] = bflo(w1.z); o[13] = bfhi(w1.z); o[14] = bflo(w1.w); o[15] = bfhi(w1.w);
}
__device__ __forceinline__ void ld16f(float (&o)[16], const float* p) {
#pragma unroll
    for (int j = 0; j < 4; ++j) { const f32x4 v = *(const f32x4*)(p + 4 * j); o[4 * j] = v[0]; o[4 * j + 1] = v[1]; o[4 * j + 2] = v[2]; o[4 * j + 3] = v[3]; }
}
__device__ __forceinline__ void st16bf(bf16* p, const float (&o)[16]) {
    *(v4u*)p = (v4u){pk2(o[0], o[1]), pk2(o[2], o[3]), pk2(o[4], o[5]), pk2(o[6], o[7])};
    *(v4u*)(p + 8) = (v4u){pk2(o[8], o[9]), pk2(o[10], o[11]), pk2(o[12], o[13]), pk2(o[14], o[15])};
}
__device__ __forceinline__ void postscan_phase(const Args& a, int gw, int NGW, int lane) {
    unsigned char* ws = a.ws;
    const bf16* Rb = (const bf16*)(ws + WS_R); const bf16* Kb = (const bf16*)(ws + WS_K); const bf16* Vb = (const bf16*)(ws + WS_V); const bf16* Gb = (const bf16*)(ws + WS_G); const bf16* Ab = (const bf16*)(ws + WS_A2);
    const bf16* Y = (const bf16*)(ws + WS_Y); bf16* A = (bf16*)(ws + WS_A);
    float ka[16], rk[16], lw[16], lb[16];
    ld16f(ka, a.in[24] + lane * 16); ld16f(rk, a.in[25] + lane * 16); ld16f(lw, a.in[26] + lane * 16); ld16f(lb, a.in[27] + lane * 16);
    for (int row = gw; row < NTOK; row += NGW) {
        const size_t off = (size_t)row * D + lane * 16;
        float y[16], r[16], k[16], v[16], g[16], av[16];
        ld16bf(y, Y + off); ld16bf(r, Rb + off); ld16bf(k, Kb + off); ld16bf(v, Vb + off); ld16bf(g, Gb + off); ld16bf(av, Ab + off);
        float s = 0.f, bd = 0.f;
#pragma unroll
        for (int i = 0; i < 16; ++i) { s += y[i]; bd += r[i] * (k[i] * ((av[i] - 1.f) * ka[i] + 1.f)) * rk[i]; }
        s += __shfl_xor(s, 1); s += __shfl_xor(s, 2); bd += __shfl_xor(bd, 1); bd += __shfl_xor(bd, 2);
        const float mean = s * (1.f / 64.f); float q = 0.f;
#pragma unroll
        for (int i = 0; i < 16; ++i) { y[i] -= mean; q += y[i] * y[i]; }
        q += __shfl_xor(q, 1); q += __shfl_xor(q, 2);
        const float rstd = 1.f / sqrtf(q * (1.f / 64.f) + GN_EPS);
        float o[16];
#pragma unroll
        for (int i = 0; i < 16; ++i) o[i] = (y[i] * rstd * lw[i] + lb[i] + bd * v[i]) * g[i];
        st16bf(A + off, o);
    }
}

__device__ __forceinline__ void conv_v_early(const Args& a, int wv, int nw, int lane) {
    bf16* VSB = (bf16*)(a.ws + WS_VSB);
    for (int r = wv; r < 16 * PAST; r += 2 * nw) {
        const int r1 = r + nw; const bool has1 = r1 < 16 * PAST;
        f32x4 x[4], y[4]; ld_row_nt(x, a.in[7] + (size_t)r * D, lane); if (has1) ld_row_nt(y, a.in[7] + (size_t)r1 * D, lane);
        bf16* dst = VSB + ((size_t)(r >> 11) * KS_ROWS + (r & 2047)) * D;
#pragma unroll
        for (int j = 0; j < 4; ++j) *(v2u*)(dst + 4 * lane + 256 * j) = (v2u){pk2(x[j][0], x[j][1]), pk2(x[j][2], x[j][3])};
        if (has1) { bf16* dst1 = VSB + ((size_t)(r1 >> 11) * KS_ROWS + (r1 & 2047)) * D;
#pragma unroll
            for (int j = 0; j < 4; ++j) *(v2u*)(dst1 + 4 * lane + 256 * j) = (v2u){pk2(y[j][0], y[j][1]), pk2(y[j][2], y[j][3])}; }
    }
}
__device__ __forceinline__ void conv_phase(const Args& a, int gw, int NGW, int lane, bool v_done) {
    unsigned char* ws = a.ws; bf16* KSB = (bf16*)(ws + WS_KSB); bf16* VSB = (bf16*)(ws + WS_VSB); bf16* QS = (bf16*)(ws + WS_QS);
    const int nconv = (v_done ? 1 : 2) * 16 * PAST;
    for (int it = gw; it < nconv; it += 2 * NGW) {
        const int it1 = it + NGW; const bool has1 = it1 < nconv;
        const int kv = it >= 16 * PAST, r = it - kv * 16 * PAST, kv1 = it1 >= 16 * PAST, r1 = it1 - kv1 * 16 * PAST;
        f32x4 x[4], y[4]; ld_row_nt(x, (kv ? a.in[7] : a.in[6]) + (size_t)r * D, lane); if (has1) ld_row_nt(y, (kv1 ? a.in[7] : a.in[6]) + (size_t)r1 * D, lane);
        bf16* dst = (kv ? VSB : KSB) + ((size_t)(r >> 11) * KS_ROWS + (r & 2047)) * D;
#pragma unroll
        for (int j = 0; j < 4; ++j) *(v2u*)(dst + 4 * lane + 256 * j) = (v2u){pk2(x[j][0], x[j][1]), pk2(x[j][2], x[j][3])};
        if (has1) { bf16* dst1 = (kv1 ? VSB : KSB) + ((size_t)(r1 >> 11) * KS_ROWS + (r1 & 2047)) * D;
#pragma unroll
            for (int j = 0; j < 4; ++j) *(v2u*)(dst1 + 4 * lane + 256 * j) = (v2u){pk2(y[j][0], y[j][1]), pk2(y[j][2], y[j][3])}; }
    }
    for (int it = gw; it < 2 * 16 * 64 + 16 * 192; it += NGW) {
        bf16* dst;
        if (it < 2048) { const int kv = it >> 10, r = it & 1023, b = r >> 6, t = r & 63; dst = (kv ? VSB : KSB) + ((size_t)b * KS_ROWS + PAST + 64 + t) * D; }
        else { const int r = it - 2048, b = r / 192, q = r % 192; dst = QS + ((size_t)b * QS_ROWS + (q < 128 ? q : q + 64)) * D; }
#pragma unroll
        for (int j = 0; j < 4; ++j) *(v2u*)(dst + 4 * lane + 256 * j) = (v2u){0u, 0u};
    }
}

__device__ __forceinline__ void attn_phase_all(const Args& a, unsigned char* lds_generic, int vcu, int G) {
    using abf = attn_body::bf16; unsigned char* ws = a.ws;
    const abf* QP = (const abf*)(ws + WS_QP); const abf* QS = (const abf*)(ws + WS_QS); const abf* KP = (const abf*)(ws + WS_KP); const abf* VP = (const abf*)(ws + WS_VP);
    const abf* KSB = (const abf*)(ws + WS_KSB); const abf* VSB = (const abf*)(ws + WS_VSB); abf* OS = (abf*)(ws + WS_OS);
    for (int v = vcu; v < 256; v += G) {
        const int bh = v >> 3, s = v & 7;
        for (int i = 0; i < 10; ++i) {
            if (i < 8) {
                const int bhp = (i < 4) ? bh : bh + 32, b = bhp >> 5, hp = bhp & 31; const int i4 = i & 3;
                const int qb = (i4 == 0) ? s : (i4 == 1) ? 15 - s : (i4 == 2) ? 16 + s : 31 - s;
                const int h = hp >> 2, c = (hp >> 1) & 1, vh = hp & 1; const int qcol = (h * 2 + c) * 64, vcol = h * 128 + vh * 64;
                const size_t r0 = (size_t)b * 8192;
                attn_body::attn_unit<8,false>(QP + (r0 + qb * 256) * 1024 + qcol, KP + r0 * 1024 + qcol, VP + r0 * 1024 + vcol, (abf*)(ws + (b ? WS_OP1 : WS_OP0)) + (size_t)(qb * 256) * 2048 + hp * 64, 4 * qb + 4, (char*)lds_generic);
            } else {
                const int u = 2 * v + (i - 8), b = u >> 5, hp = u & 31;
                const int h = hp >> 2, c = (hp >> 1) & 1, vh = hp & 1; const int qcol = (h * 2 + c) * 64, vcol = h * 128 + vh * 64;
                attn_body::attn_unit<8,true>(QS + (size_t)b * QS_ROWS * 1024 + qcol, KSB + (size_t)b * KS_ROWS * 1024 + qcol, VSB + (size_t)b * KS_ROWS * 1024 + vcol, OS + (size_t)b * QS_ROWS * 2048 + hp * 64, 34, (char*)lds_generic);
            }
        }
    }
}
__device__ __forceinline__ void combine_phase(const Args& a, int gw, int NGW, int lane) {
    unsigned char* ws = a.ws; const bf16* OS = (const bf16*)(ws + WS_OS); bf16* A = (bf16*)(ws + WS_A);
    const float* lp = a.in[34];
    const float lam = __builtin_expf(wave_sum(lp[lane] * lp[64 + lane])) - __builtin_expf(wave_sum(lp[128 + lane] * lp[192 + lane])) + LAM_INIT;
    const int h = lane >> 3, dv0 = (lane & 7) * 16;
    float g[16]; ld16f(g, a.in[35] + dv0);
    for (int row = gw; row < NTOK; row += NGW) {
        const bool smp = row >= NP; const int rs = row - NP;
        const bf16* src = smp ? OS + ((size_t)(rs >> 6) * QS_ROWS + 128 + (rs & 63)) * 2048 : (const bf16*)(ws + ((row >> 13) ? WS_OP1 : WS_OP0)) + (size_t)(row & 8191) * 2048;
        float o0[16], o1[16]; ld16bf(o0, src + h * 256 + dv0); ld16bf(o1, src + h * 256 + 128 + dv0);
        float q = 0.f;
#pragma unroll
        for (int i = 0; i < 16; ++i) { o0[i] -= lam * o1[i]; q += o0[i] * o0[i]; }
        q += __shfl_xor(q, 1); q += __shfl_xor(q, 2); q += __shfl_xor(q, 4);
        const float rstd = 1.f / sqrtf(q * (1.f / 128.f) + NORM_EPS) * (1.f - LAM_INIT);
#pragma unroll
        for (int i = 0; i < 16; ++i) o0[i] = o0[i] * rstd * g[i];
        st16bf(A + (size_t)row * D + h * 128 + dv0, o0);
    }
}

#define XB_TMO      128
#define XB_XCNT(j)  (256  + 64 * (j))
#define XB_XSUB(j)  (1280 + 64 * (j))
#define XB_XGEN(j)  (2304 + 64 * (j))
#define XB_TOP      3328
#define XB_TOPGEN   3392
#define XCD_BAR_WORDS 3456
#define XB_SPIN_CAP (1u << 18)

__device__ __forceinline__ unsigned xb_ld(unsigned* p)              { return __hip_atomic_load(p, __ATOMIC_RELAXED, __HIP_MEMORY_SCOPE_AGENT); }
__device__ __forceinline__ unsigned xb_add(unsigned* p, unsigned v) { return __hip_atomic_fetch_add(p, v, __ATOMIC_RELAXED, __HIP_MEMORY_SCOPE_AGENT); }
__device__ __forceinline__ unsigned xb_xcc_id() { return (unsigned)__builtin_amdgcn_s_getreg((3 << 11) | 20) & 0xFu; }
#define XB_SPIN(cond, bar) do { unsigned _sp = 0; while (cond) { __builtin_amdgcn_s_sleep(1); \
    if ((++_sp & 255u) == 0u) { if (xb_ld(&(bar)[XB_TMO])) break; if (_sp > XB_SPIN_CAP) { atomicAdd(&(bar)[XB_TMO], 1u); break; } } } } while (0)

struct XcdBarrier {
    unsigned* bar; unsigned x;
    volatile LAS unsigned* st;
};

__device__ __forceinline__ XcdBarrier xcd_barrier_post(unsigned* bar, volatile LAS unsigned* st) {
    XcdBarrier b; b.bar = bar; b.x = xb_xcc_id(); b.st = st;
    if (threadIdx.x == 0) (void)xb_add(&bar[XB_XCNT(b.x)], 1u);
    return b;
}
__device__ __forceinline__ void xcd_barrier_complete(unsigned* bar, unsigned x, unsigned& nloc, unsigned& nx) {
    const unsigned G = gridDim.x * gridDim.y * gridDim.z;
    unsigned sum, cnt, mine, sp = 0u;
    for (;;) {
        sum = 0u; cnt = 0u; mine = 0u;
#pragma unroll
        for (unsigned j = 0; j < 16; ++j) { const unsigned c = xb_ld(&bar[XB_XCNT(j)]); sum += c; cnt += (c > 0u) ? 1u : 0u; mine = (j == x) ? c : mine; }
        if (sum == G) break;
        __builtin_amdgcn_s_sleep(1);
        if ((++sp & 255u) == 0u) { if (xb_ld(&bar[XB_TMO])) break; if (sp > XB_SPIN_CAP) { atomicAdd(&bar[XB_TMO], 1u); break; } }
    }
    nloc = mine > 0u ? mine : 1u; nx = cnt > 0u ? cnt : 1u;
}

__device__ __forceinline__ void xcd_barrier(const XcdBarrier& b) {
    asm volatile("s_waitcnt vmcnt(0)" ::: "memory");
    __syncthreads();
    if (threadIdx.x == 0) {
        unsigned* bar = b.bar;
        __builtin_amdgcn_s_waitcnt(0);
        unsigned nloc = b.st[0], nx = b.st[1];
        if (nloc == 0u) { xcd_barrier_complete(bar, b.x, nloc, nx); b.st[0] = nloc; b.st[1] = nx; }
        const unsigned old = xb_add(&bar[XB_XSUB(b.x)], 1u);
        const unsigned gen = old / nloc;
        if (old + 1u == (gen + 1u) * nloc) {
            __builtin_amdgcn_fence(__ATOMIC_RELEASE, "agent");
            asm volatile("s_waitcnt vmcnt(0)" ::: "memory");
            const unsigned og = xb_add(&bar[XB_TOP], 1u);
            const unsigned tg = og / nx;
            if (og + 1u == (tg + 1u) * nx) xb_add(&bar[XB_TOPGEN], 1u);
            else XB_SPIN(xb_ld(&bar[XB_TOPGEN]) == tg, bar);
            __builtin_amdgcn_fence(__ATOMIC_ACQUIRE, "agent");
            xb_add(&bar[XB_XGEN(b.x)], 1u);
            asm volatile("s_waitcnt vmcnt(0)" ::: "memory");
        } else {
            XB_SPIN(xb_ld(&bar[XB_XGEN(b.x)]) == gen, bar);
            __builtin_amdgcn_fence(__ATOMIC_ACQUIRE, "agent");
            asm volatile("s_waitcnt vmcnt(0)" ::: "memory");
        }
    }
    __syncthreads();
}

constexpr int CW_BAR = 4096; constexpr int MISC_OFF = 131072 + 320;
enum { NPHASE = 26 };
#ifndef DBG_HI
#define DBG_HI NPHASE
#endif
__global__ void __launch_bounds__(NWAVES * 64) mega_fwd(Args a) {
    extern __shared__ __attribute__((aligned(16))) unsigned char lds[];
    cg::grid_group grid = cg::this_grid();
    LAS unsigned char* L = (LAS unsigned char*)lds;
    const int tid = threadIdx.x, lane = tid & 63, wave = __builtin_amdgcn_readfirstlane(tid >> 6);
    const int G = gridDim.x; const int bx = blockIdx.x; const int vcu = (G % 8 == 0) ? (bx % 8) * (G / 8) + bx / 8 : bx;
    const int gw = vcu * NWAVES + wave, NGW = G * NWAVES;
    unsigned char* ws = a.ws; bf16* WB = (bf16*)(ws + WS_W);
    const int lo = a.ph_lo, hi = a.ph_hi;
    volatile LAS unsigned* MISC = (volatile LAS unsigned*)(L + MISC_OFF);
    if (tid < 32) MISC[tid] = 0u;
    __syncthreads();
    XcdBarrier bar = xcd_barrier_post((unsigned*)ws + CW_BAR, MISC + 8);
    grid.sync();
    const bf16* Abuf = (const bf16*)(ws + WS_A);
#define PH(k) if (lo <= (k) && (k) < hi)
#define SYNC(k) do { if ((k) + 1 < hi) { xcd_barrier(bar); } } while (0)
#define RUN_GEMM(MODE, Aptr, Bptr, NN, KK, cofs) do { pg8::Gemm g{Aptr, Bptr, NTOK, NN, KK, KK}; pg8::StaticOrder S; S.init(NTOK, NN, G, (bx + (cofs)) % G); \
        pg8::gemm_phase<EpiG<MODE>, pg8::StaticOrder, true, true>(L, g, S, E); } while (0)
#define FFN_IN(k, f) PH(k) { if (EN_GEMM) { EpiG<EM_H> E{ws, nullptr, nullptr, nullptr}; RUN_GEMM(EM_H, Abuf, WB + WE_IN + (size_t)(f) * 5632 * 1024, 5632, 1024, 0); } SYNC(k); }
#define RUN_SPLIT(Aptr, Bptr, KK, PP) do { { EpiG<EM_RAW> E{ws, (float*)(ws + WS_RAW), nullptr, nullptr}; pg8::Gemm g{Aptr, Bptr, NP, 1024, KK, KK}; pg8::StaticOrder S; S.init(NP, 1024, G, bx); \
          pg8::gemm_phase<EpiG<EM_RAW>, pg8::StaticOrder, true, true>(L, g, S, E); } \
        { EpiG<EM_ATOM> E{ws, (float*)(ws + WS_PART), nullptr, nullptr}; pg8::Gemm g{(Aptr) + (size_t)NP * (KK), Bptr, NS, 1024, (KK) / (PP), KK}; pg8::SplitOrder S{PP, (KK) / (PP), G, bx}; \
          pg8::gemm_phase<EpiG<EM_ATOM>, pg8::SplitOrder, true, true>(L, g, S, E); } } while (0)
#define ZERO_RAW_SAMPLE() do { v4u* z_ = (v4u*)(ws + WS_RAW + (size_t)NP * D * 4); for (int i_ = gw * 64 + lane; i_ < NS * D / 4; i_ += NGW * 64) z_[i_] = (v4u){0u, 0u, 0u, 0u}; } while (0)
#define FFN_OUT(k, f) PH(k) { if (EN_GEMM) { RUN_SPLIT((const bf16*)(ws + WS_H), WB + WE_OUT + (size_t)(f) * 1024 * DFF, DFF, 11); } SYNC(k); }
#define PROJ_RAW(k, Woff) PH(k) { if (EN_GEMM) { RUN_SPLIT(Abuf, WB + (Woff), 1024, 4); } SYNC(k); }
    PH(0) { if (EN_P0) p0_phase(a, L, tid, wave, lane, vcu, G); SYNC(0); }
    PH(1) { rowpass<0>(a, gw, NGW, lane); SYNC(1); }
    FFN_IN(2, 0)
    FFN_OUT(3, 0)
    PH(4) { rowpass<1>(a, gw, NGW, lane); SYNC(4); }
    PH(5) { if (EN_GEMM) { EpiG<EM_R1> E{ws, nullptr, nullptr, nullptr}; RUN_GEMM(EM_R1, Abuf, WB + WE_RKV, 3328, 2048, 0); }
             if (G == 256 && bx >= 116) conv_v_early(a, (bx - 116) * NWAVES + wave, 140 * NWAVES, lane);
             SYNC(5); }
    PH(6) { if (EN_GEMM) { EpiG<EM_R2> E{ws, (float*)(ws + WS_A), a.in[15], a.in[18]}; RUN_GEMM(EM_R2, (const bf16*)(ws + WS_LORA), WB + WE_L2, 3072, 256, 0); } SYNC(6); }
    PH(7) { if (EN_SCAN) scan_phase(a, L, wave, lane, vcu, G); SYNC(7); }
    PH(8) { if (EN_POST) postscan_phase(a, gw, NGW, lane); SYNC(8); }
    PROJ_RAW(9, WE_WO)
    PH(10) { rowpass<2>(a, gw, NGW, lane); SYNC(10); }
    FFN_IN(11, 1)
    FFN_OUT(12, 1)
    PH(13) { rowpass<3>(a, gw, NGW, lane); SYNC(13); }
    FFN_IN(14, 2)
    FFN_OUT(15, 2)
    PH(16) { rowpass<4>(a, gw, NGW, lane); SYNC(16); }
    PH(17) { if (G != 256) conv_phase(a, gw, NGW, lane, false);
             if (EN_GEMM) { EpiG<EM_KV> E{ws, a.out, nullptr, nullptr}; RUN_GEMM(EM_KV, (const bf16*)(ws + WS_A2), WB + WE_KV, 2048, 1024, 0); } }
    PH(18) { if (EN_GEMM) { EpiG<EM_Q> E{ws, nullptr, nullptr, nullptr}; RUN_GEMM(EM_Q, Abuf, WB + WE_Q, 1024, 1024, 128); }
             if (G == 256 && !(bx < 32 || (bx >= 128 && bx < 144))) { const int rk = (bx < 128) ? bx - 32 : 96 + (bx - 144); conv_phase(a, rk * NWAVES + wave, 208 * NWAVES, lane, true); }
             SYNC(18); }
    PH(19) { if (EN_ATTN) attn_phase_all(a, lds, vcu, G); SYNC(19); }
    PH(20) { if (EN_COMB) combine_phase(a, gw, NGW, lane); SYNC(20); }
    PROJ_RAW(21, WE_DO)
    PH(22) { rowpass<5>(a, gw, NGW, lane); SYNC(22); }
    FFN_IN(23, 3)
    FFN_OUT(24, 3)
    PH(25) { rowpass<6>(a, gw, NGW, lane); }
#ifdef DBG_OFF0
    xcd_barrier(bar);
    { const v4u* s0 = (const v4u*)(ws + (size_t)DBG_OFF0); v4u* d0 = (v4u*)(a.out + O_KP); const size_t n0 = (size_t)DBG_BYTES0 / 16;
      for (size_t i = (size_t)gw * 64 + lane; i < n0; i += (size_t)NGW * 64) d0[i] = s0[i];
      const v4u* s1 = (const v4u*)(ws + (size_t)DBG_OFF1); v4u* d1 = d0 + n0; const size_t n1 = (size_t)DBG_BYTES1 / 16;
      for (size_t i = (size_t)gw * 64 + lane; i < n1; i += (size_t)NGW * 64) d1[i] = s1[i]; }
#endif
}

extern "C" void kernel_launch(void* const* d_in, const int* in_sizes, int n_in, void* d_out, int out_size, void* d_ws, size_t ws_size, hipStream_t stream) {
    static int grid = 0;
    if (grid == 0) {
        if (n_in != 37 || (size_t)out_size != O_TOTAL || ws_size < WS_END) { fprintf(stderr, "kernel_launch: unexpected problem: n_in %d out %d ws %zu (need %zu)\n", n_in, out_size, ws_size, (size_t)WS_END); grid = -1; return; }
        int dev = 0, cus = 0, per_cu = 0;
        if (hipGetDevice(&dev) != hipSuccess || hipDeviceGetAttribute(&cus, hipDeviceAttributeMultiprocessorCount, dev) != hipSuccess) { grid = -1; return; }
        if (hipFuncSetAttribute((const void*)mega_fwd, hipFuncAttributeMaxDynamicSharedMemorySize, LDS_BYTES) != hipSuccess) { fprintf(stderr, "kernel_launch: hipFuncSetAttribute failed\n"); grid = -1; return; }
        if (hipOccupancyMaxActiveBlocksPerMultiprocessor(&per_cu, (const void*)mega_fwd, NWAVES * 64, LDS_BYTES) != hipSuccess || per_cu < 1) { fprintf(stderr, "kernel_launch: occupancy query failed (%d)\n", per_cu); (void)hipGetLastError(); grid = -1; return; }
        grid = cus;
    }
    if (grid < 0) return;
    if (hipMemsetAsync(d_ws, 0, 1u << 20, stream) != hipSuccess) { fprintf(stderr, "kernel_launch: memset failed\n"); return; }
    Args a{};
    for (int i = 0; i < 37; ++i) a.in[i] = (const float*)d_in[i];
    a.out = (float*)d_out; a.ws = (unsigned char*)d_ws; a.ph_lo = 0; a.ph_hi = DBG_HI;
    void* args[] = {&a};
    hipError_t e = hipLaunchCooperativeKernel((const void*)mega_fwd, dim3(grid), dim3(NWAVES * 64), args, LDS_BYTES, stream);
    if (e != hipSuccess) fprintf(stderr, "kernel_launch: cooperative launch failed: %s (grid %d)\n", hipGetErrorString(e), grid);
}
```
